# Optimizing an MI355X kernel written in HIP

```python
import math
import jax, jax.numpy as jnp
from jax import lax
import numpy as np

D_MODEL = 1024
BATCH = 8
SEQ = 2048
DEPTH = 2
DEC_BATCH = 128
DEC_SEQ = 1
PAST_LEN = 16384
PAGE_SIZE = 128

N_MIXERS = 2
N_POOL_LAYERS = (DEPTH + 1) // 2
N_DN_LAYERS = DEPTH // 2
POOL_WINDOWS = (2, 4, 8, 16)
N_POOL_GROUPS = len(POOL_WINDOWS)
POOL_GD = D_MODEL // N_POOL_GROUPS
POOL_BUF = max(POOL_WINDOWS) - 1
DN_HEAD_DIM = 128
DN_HEADS = D_MODEL // DN_HEAD_DIM
DN_DIM = DN_HEADS * DN_HEAD_DIM
DN_CONV = 4
DN_CHUNK = 64
DT_MIN = 0.001
DT_MAX = 0.1
D_FF = ((8 * D_MODEL // 3 + 127) // 128) * 128
FFN_CONV = 3
NORM_EPS = 1e-6

kernel_name = "hybrid_pool_gdn_convffn_step"


def rms_norm(x, w):
    xf = x.astype(jnp.float32)
    y = xf * lax.rsqrt(jnp.mean(xf * xf, axis=-1, keepdims=True) + NORM_EPS)
    return (y * w.astype(jnp.float32)).astype(x.dtype)


def l2_norm(x):
    xf = x.astype(jnp.float32)
    return xf * lax.rsqrt(jnp.sum(xf * xf, axis=-1, keepdims=True) + NORM_EPS)


def causal_depthwise_conv(xx, w, t):
    out = xx[:, 0:t] * w[0]
    for j in range(1, w.shape[0]):
        out = out + xx[:, j:j + t] * w[j]
    return out


def pool_mixer(xn, buf, pos0, w_grp, scale):
    b, t, d = xn.shape
    xx = jnp.concatenate([buf.astype(xn.dtype), xn], axis=1)
    cs = jnp.cumsum(xx.astype(jnp.float32), axis=1)
    cs = jnp.pad(cs, ((0, 0), (1, 0), (0, 0)))
    csg = cs.reshape(b, POOL_BUF + 1 + t, N_POOL_GROUPS, POOL_GD)
    xg = xn.astype(jnp.float32).reshape(b, t, N_POOL_GROUPS, POOL_GD)
    pos = pos0 + jnp.arange(t)
    diffs = []
    for g, w in enumerate(POOL_WINDOWS):
        s = csg[:, POOL_BUF + 1:POOL_BUF + 1 + t, g] - csg[:, POOL_BUF + 1 - w:POOL_BUF + 1 - w + t, g]
        cnt = jnp.minimum(w, pos + 1).astype(jnp.float32)[None, :, None]
        diffs.append(s / cnt - xg[:, :, g])
    dg = jnp.stack(diffs, axis=2)
    y = jnp.einsum('btgc,gcd->btgd', dg, w_grp.astype(jnp.float32)).reshape(b, t, d)
    out = (y * scale.astype(jnp.float32)).astype(xn.dtype)
    return out, xx[:, -POOL_BUF:]


def gated_delta_rule(q, k, v, g, beta, s0):
    b, t, h, _ = q.shape
    dv = v.shape[-1]
    c = min(DN_CHUNK, t)
    pad = (-t) % c
    nc = (t + pad) // c

    def chunks(a):
        a = jnp.pad(a.astype(jnp.float32), [(0, 0), (0, pad)] + [(0, 0)] * (a.ndim - 2))
        a = a.reshape((b, nc, c) + a.shape[2:])
        return jnp.moveaxis(a, 3, 2)

    q, k, v, g, beta = chunks(q), chunks(k), chunks(v), chunks(g), chunks(beta)
    gc = jnp.cumsum(g, axis=-1)
    incl = jnp.tril(jnp.ones((c, c), dtype=bool))
    strict = jnp.tril(jnp.ones((c, c), dtype=bool), k=-1)
    decay = jnp.exp(jnp.where(incl, gc[..., :, None] - gc[..., None, :], -jnp.inf))
    kb = k * beta[..., None]
    vb = v * beta[..., None]
    a_mat = jnp.where(strict, jnp.einsum('bnhid,bnhjd->bnhij', kb, k) * decay, 0.0) + jnp.eye(c, dtype=jnp.float32)
    rhs = jnp.concatenate([vb, kb * jnp.exp(gc)[..., None]], axis=-1)
    sol = lax.linalg.triangular_solve(a_mat, rhs, left_side=True, lower=True, unit_diagonal=True)
    u_in, w_in = sol[..., :dv], sol[..., dv:]
    qk = jnp.einsum('bnhid,bnhjd->bnhij', q, k) * decay
    q_dec = q * jnp.exp(gc)[..., None]
    g_last = gc[..., -1]
    k_dec = k * jnp.exp(g_last[..., None] - gc)[..., None]

    def step(s, xs):
        u_c, w_c, qk_c, qd_c, kd_c, gl_c = xs
        u = u_c - jnp.einsum('bhck,bhkv->bhcv', w_c, s)
        o = jnp.einsum('bhck,bhkv->bhcv', qd_c, s) + jnp.einsum('bhij,bhjv->bhiv', qk_c, u)
        s = s * jnp.exp(gl_c)[..., None, None] + jnp.einsum('bhck,bhcv->bhkv', kd_c, u)
        return s, o

    xs = tuple(jnp.moveaxis(a, 1, 0) for a in (u_in, w_in, qk, q_dec, k_dec, g_last))
    s_final, o = lax.scan(step, s0.astype(jnp.float32), xs)
    o = jnp.transpose(o, (1, 0, 3, 2, 4)).reshape(b, nc * c, h, dv)[:, :t]
    return o, s_final


def deltanet_mixer(xn, conv_buf, s0, w_in, conv_w, a_log, dt_bias, o_norm_w, w_out):
    b, t, _ = xn.shape
    proj = xn @ w_in
    qkv, z, a, bb = jnp.split(proj, [3 * DN_DIM, 4 * DN_DIM, 4 * DN_DIM + DN_HEADS], axis=-1)
    qkv_all = jnp.concatenate([conv_buf.astype(qkv.dtype), qkv], axis=1)
    qkv_c = jax.nn.silu(causal_depthwise_conv(qkv_all, conv_w, t))
    q, k, v = jnp.split(qkv_c, 3, axis=-1)
    q = l2_norm(q.reshape(b, t, DN_HEADS, DN_HEAD_DIM)) * (DN_HEAD_DIM ** -0.5)
    k = l2_norm(k.reshape(b, t, DN_HEADS, DN_HEAD_DIM))
    v = v.reshape(b, t, DN_HEADS, DN_HEAD_DIM)
    beta = jax.nn.sigmoid(bb.astype(jnp.float32))
    g = -jnp.exp(a_log.astype(jnp.float32)) * jax.nn.softplus(a.astype(jnp.float32) + dt_bias.astype(jnp.float32))
    o, s_new = gated_delta_rule(q, k, v, g, beta, s0)
    o = rms_norm(o, o_norm_w) * jax.nn.silu(z.astype(jnp.float32).reshape(b, t, DN_HEADS, DN_HEAD_DIM))
    out = o.reshape(b, t, DN_DIM).astype(xn.dtype) @ w_out
    return out, qkv_all[:, -(DN_CONV - 1):], s_new.astype(s0.dtype)


def conv_ffn(xn, buf, w_up, conv_w, conv_b, w_down):
    t = xn.shape[1]
    hh = jnp.concatenate([buf.astype(xn.dtype), xn @ w_up], axis=1)
    c = causal_depthwise_conv(hh, conv_w, t) + conv_b
    gate, val = jnp.split(c, 2, axis=-1)
    return (jax.nn.silu(gate) * val) @ w_down, hh[:, -(FFN_CONV - 1):]


def trunk(x, pool_buf, dn_conv, dn_ssm, ffn_conv, pos0, params):
    (norm1_w, norm2_w, final_norm_w, pool_w, pool_scale, dn_w_in, dn_conv_w, dn_a_log,
     dn_dt_bias, dn_o_norm_w, dn_w_out, ffn_w_up, ffn_conv_w, ffn_conv_b, ffn_w_down) = params
    new_pool, new_dnc, new_dns, new_ffn = [], [], [], []
    for i in range(DEPTH):
        h = rms_norm(x, norm1_w[i])
        j = i // N_MIXERS
        if i % N_MIXERS == 0:
            out, nb = pool_mixer(h, pool_buf[j], pos0, pool_w[j], pool_scale[j])
            new_pool.append(nb)
        else:
            out, ncb, ns = deltanet_mixer(h, dn_conv[j], dn_ssm[j], dn_w_in[j], dn_conv_w[j], dn_a_log[j],
                                          dn_dt_bias[j], dn_o_norm_w[j], dn_w_out[j])
            new_dnc.append(ncb)
            new_dns.append(ns)
        x = x + out
        out, nf = conv_ffn(rms_norm(x, norm2_w[i]), ffn_conv[i], ffn_w_up[i], ffn_conv_w[i], ffn_conv_b[i], ffn_w_down[i])
        x = x + out
        new_ffn.append(nf)
    y = rms_norm(x, final_norm_w)
    return y, jnp.stack(new_pool), jnp.stack(new_dnc), jnp.stack(new_dns), jnp.stack(new_ffn)


def setup_inputs(seed: int = 0) -> dict:
    key = jax.random.key(seed)
    ks = jax.random.split(key, 22)
    f32 = jnp.float32

    def nrm(k, shape, s):
        return jax.random.normal(k, shape, f32) * s

    dn_in_cols = 4 * DN_DIM + 2 * DN_HEADS
    dt = jnp.exp(jax.random.uniform(ks[10], (N_DN_LAYERS, DN_HEADS), f32)
                 * (math.log(DT_MAX) - math.log(DT_MIN)) + math.log(DT_MIN))
    return {
        'x_prompt': nrm(ks[0], (BATCH, SEQ, D_MODEL), 1.0),
        'x_sample': nrm(ks[1], (DEC_BATCH, DEC_SEQ, D_MODEL), 1.0),
        'state_pool_buf': nrm(ks[2], (N_POOL_LAYERS, DEC_BATCH, POOL_BUF, D_MODEL), 1.0),
        'state_dn_conv': nrm(ks[3], (N_DN_LAYERS, DEC_BATCH, DN_CONV - 1, 3 * DN_DIM), 1.0),
        'state_dn_ssm': nrm(ks[4], (N_DN_LAYERS, DEC_BATCH, DN_HEADS, DN_HEAD_DIM, DN_HEAD_DIM), DN_HEAD_DIM ** -0.5),
        'state_ffn_conv': nrm(ks[5], (DEPTH, DEC_BATCH, FFN_CONV - 1, 2 * D_FF), 1.0),
        'norm1_w': 1.0 + nrm(ks[6], (DEPTH, D_MODEL), 0.02),
        'norm2_w': 1.0 + nrm(ks[7], (DEPTH, D_MODEL), 0.02),
        'final_norm_w': 1.0 + nrm(ks[8], (D_MODEL,), 0.02),
        'pool_w': nrm(ks[9], (N_POOL_LAYERS, N_POOL_GROUPS, POOL_GD, POOL_GD), POOL_GD ** -0.5),
        'pool_scale': 1.0 + nrm(ks[11], (N_POOL_LAYERS, D_MODEL), 0.1),
        'dn_w_in': nrm(ks[12], (N_DN_LAYERS, D_MODEL, dn_in_cols), D_MODEL ** -0.5),
        'dn_conv_w': nrm(ks[13], (N_DN_LAYERS, DN_CONV, 3 * DN_DIM), DN_CONV ** -0.5),
        'dn_a_log': jnp.log(jax.random.uniform(ks[14], (N_DN_LAYERS, DN_HEADS), f32, 1.0, 16.0)),
        'dn_dt_bias': dt + jnp.log(-jnp.expm1(-dt)),
        'dn_o_norm_w': 1.0 + nrm(ks[15], (N_DN_LAYERS, DN_HEAD_DIM), 0.02),
        'dn_w_out': nrm(ks[16], (N_DN_LAYERS, DN_DIM, D_MODEL), DN_DIM ** -0.5),
        'ffn_w_up': nrm(ks[17], (DEPTH, D_MODEL, 2 * D_FF), D_MODEL ** -0.5),
        'ffn_conv_w': nrm(ks[18], (DEPTH, FFN_CONV, 2 * D_FF), FFN_CONV ** -0.5),
        'ffn_conv_b': nrm(ks[19], (DEPTH, 2 * D_FF), 0.01),
        'ffn_w_down': nrm(ks[20], (DEPTH, D_FF, D_MODEL), D_FF ** -0.5),
    }


def reference(x_prompt, x_sample, state_pool_buf, state_dn_conv, state_dn_ssm, state_ffn_conv,
              norm1_w, norm2_w, final_norm_w, pool_w, pool_scale, dn_w_in, dn_conv_w, dn_a_log,
              dn_dt_bias, dn_o_norm_w, dn_w_out, ffn_w_up, ffn_conv_w, ffn_conv_b, ffn_w_down):
    params = (norm1_w, norm2_w, final_norm_w, pool_w, pool_scale, dn_w_in, dn_conv_w, dn_a_log,
              dn_dt_bias, dn_o_norm_w, dn_w_out, ffn_w_up, ffn_conv_w, ffn_conv_b, ffn_w_down)
    bp, dt = x_prompt.shape[0], x_prompt.dtype
    zero_pool = jnp.zeros((N_POOL_LAYERS, bp, POOL_BUF, D_MODEL), dt)
    zero_dnc = jnp.zeros((N_DN_LAYERS, bp, DN_CONV - 1, 3 * DN_DIM), dt)
    zero_dns = jnp.zeros((N_DN_LAYERS, bp, DN_HEADS, DN_HEAD_DIM, DN_HEAD_DIM), jnp.float32)
    zero_ffn = jnp.zeros((DEPTH, bp, FFN_CONV - 1, 2 * D_FF), dt)
    y_prompt, pool_p, dnc_p, dns_p, ffn_p = trunk(x_prompt, zero_pool, zero_dnc, zero_dns, zero_ffn, 0, params)
    y_sample, pool_s, dnc_s, dns_s, ffn_s = trunk(x_sample, state_pool_buf, state_dn_conv, state_dn_ssm,
                                                  state_ffn_conv, PAST_LEN, params)
    return (y_prompt, y_sample, pool_p, pool_s, dnc_p, dnc_s, dns_p, dns_s, ffn_p, ffn_s)
```

```cpp
#include <hip/hip_runtime.h>
#include <hip/hip_cooperative_groups.h>
#include <cstdio>
#include <cstdint>
namespace cg = cooperative_groups;

typedef unsigned short bf16_t;
typedef short bf16x8 __attribute__((ext_vector_type(8)));
typedef float f32x4 __attribute__((ext_vector_type(4)));
typedef unsigned u32x4 __attribute__((ext_vector_type(4)));
typedef unsigned u32x2 __attribute__((ext_vector_type(2)));

constexpr int DM = 1024, TSEQ = 2048, NBP = 8, MP = 16384, MS = 128, MTOT = 16512;
constexpr int DFF = 2816, DFF2 = 5632, DNIN = 4112, DNIN_PAD = 4224;
constexpr int LDS_BYTES = 69632;
constexpr int TLD = 132;
constexpr size_t O_YP = 0, O_YS = O_YP + (size_t)MP * DM, O_POOLP = O_YS + (size_t)MS * DM, O_POOLS = O_POOLP + (size_t)NBP * 15 * DM,
                 O_DNCP = O_POOLS + (size_t)MS * 15 * DM, O_DNCS = O_DNCP + (size_t)NBP * 3 * 3072, O_DNSP = O_DNCS + (size_t)MS * 3 * 3072,
                 O_DNSS = O_DNSP + (size_t)NBP * 8 * 128 * 128, O_FFNP = O_DNSS + (size_t)MS * 8 * 128 * 128, O_FFNS = O_FFNP + (size_t)2 * NBP * 2 * DFF2;

struct Params {
  const float *xp, *xs, *st_pool, *st_dnc, *st_ssm, *st_ffn;
  const float *norm1_w, *norm2_w, *final_w, *pool_w, *pool_scale, *dn_w_in, *dn_conv_w, *dn_a_log, *dn_dt_bias, *dn_o_norm_w, *dn_w_out,
      *ffn_w_up, *ffn_conv_w, *ffn_conv_b, *ffn_w_down;
  float* out;
  bf16_t *WpoolT, *WupT0, *WupT1, *WdnT0, *WdnT1, *WinT, *WoutT;
  bf16_t *actA, *act, *qb, *kb, *vb, *zb, *uT, *win, *qkb;
  float *rstd, *gbuf, *betabuf, *gcbuf, *osamp, *part;
  unsigned* bar;
  int phase_lo, phase_hi;
};

__device__ __forceinline__ float bf2f(bf16_t b) { return __uint_as_float(((unsigned)b) << 16); }
typedef float f32x2 __attribute__((ext_vector_type(2)));
typedef __bf16 bf16x2_t __attribute__((ext_vector_type(2)));
__device__ __forceinline__ unsigned pk_bf16(float lo, float hi) { const f32x2 v = {lo, hi}; const bf16x2_t b = __builtin_convertvector(v, bf16x2_t); return __builtin_bit_cast(unsigned, b); }
__device__ __forceinline__ bf16_t f2bf(float x) { return (bf16_t)(pk_bf16(x, 0.f) & 0xffffu); }
template <int CTRL> __device__ __forceinline__ float dpp_add(float v) {
  return v + __builtin_bit_cast(float, __builtin_amdgcn_update_dpp(0, __builtin_bit_cast(int, v), CTRL, 0xF, 0xF, true));
}
__device__ __forceinline__ float wave_sum(float v) {
  v = dpp_add<0xB1>(v);
  v = dpp_add<0x4E>(v);
  v = dpp_add<0x141>(v);
  v = dpp_add<0x140>(v);
  const int vi = __builtin_bit_cast(int, v);
  const float r0 = __builtin_bit_cast(float, __builtin_amdgcn_readlane(vi, 0)), r1 = __builtin_bit_cast(float, __builtin_amdgcn_readlane(vi, 16));
  const float r2 = __builtin_bit_cast(float, __builtin_amdgcn_readlane(vi, 32)), r3 = __builtin_bit_cast(float, __builtin_amdgcn_readlane(vi, 48));
  return (r0 + r1) + (r2 + r3);
}
__device__ __forceinline__ float silu_f(float x) { return x * __builtin_amdgcn_rcpf(1.f + __expf(-x)); }
__device__ __forceinline__ f32x4 mfma16(bf16x8 a, bf16x8 b, f32x4 c) { return __builtin_amdgcn_mfma_f32_16x16x32_bf16(a, b, c, 0, 0, 0); }

#define LAS __attribute__((address_space(3)))
__device__ __forceinline__ void gemm_mainloop(unsigned char* lds, const bf16_t* __restrict__ A, int lda, const int (&arow)[4], int acol0,
                                              const bf16_t* __restrict__ Bt, int ldb, int n0, int bcol0, int K, f32x4 (&acc)[4][4]) {
  const int tid = threadIdx.x, lane = tid & 63, w = tid >> 6, wm = w >> 1, wn = w & 1, r16 = lane & 15, quad = lane >> 4;
  const int lrow = tid >> 3;
  const int chl = (tid & 7) ^ ((lrow >> 1) & 7);
  const bf16_t* pa[4]; const bf16_t* pb[4];
#pragma unroll
  for (int i = 0; i < 4; ++i) { pa[i] = A + (size_t)arow[i] * lda + acol0 + chl * 8; pb[i] = Bt + (size_t)(n0 + lrow + 32 * i) * ldb + bcol0 + chl * 8; }
  LAS unsigned char* sA = (LAS unsigned char*)lds; LAS unsigned char* sB = sA + 32768;
  const unsigned wbase = (unsigned)__builtin_amdgcn_readfirstlane(w) * 1024u;
#pragma unroll
  for (int mi = 0; mi < 4; ++mi)
#pragma unroll
    for (int ni = 0; ni < 4; ++ni) acc[mi][ni] = (f32x4){0.f, 0.f, 0.f, 0.f};
#pragma unroll
  for (int i = 0; i < 4; ++i) {
    __builtin_amdgcn_global_load_lds((const unsigned*)pa[i], (LAS unsigned*)(sA + wbase + i * 4096), 16, 0, 0);
    __builtin_amdgcn_global_load_lds((const unsigned*)pb[i], (LAS unsigned*)(sB + wbase + i * 4096), 16, 0, 0);
  }
  __syncthreads();
  const int nk = K >> 6;
  const unsigned a_rd = (wm * 64 + r16) * 128, b_rd = (wn * 64 + r16) * 128; const int sw = r16 >> 1;
  for (int kt = 0; kt < nk; ++kt) {
    const int cur = kt & 1;
    const LAS unsigned char* cA = sA + cur * 16384 + a_rd; const LAS unsigned char* cB = sB + cur * 16384 + b_rd;
    {
      bf16x8 af[2][4], bfr[2][4];
#pragma unroll
      for (int ks = 0; ks < 2; ++ks) {
        const unsigned co = (unsigned)(((ks * 4 + quad) ^ sw) << 4);
#pragma unroll
        for (int mi = 0; mi < 4; ++mi) af[ks][mi] = *(const LAS bf16x8*)(cA + mi * 2048 + co);
#pragma unroll
        for (int ni = 0; ni < 4; ++ni) bfr[ks][ni] = *(const LAS bf16x8*)(cB + ni * 2048 + co);
      }
      if (kt + 1 < nk) {
        const int k0 = (kt + 1) << 6;
#pragma unroll
        for (int i = 0; i < 4; ++i) {
          __builtin_amdgcn_global_load_lds((const unsigned*)(pa[i] + k0), (LAS unsigned*)(sA + (cur ^ 1) * 16384 + wbase + i * 4096), 16, 0, 0);
          __builtin_amdgcn_global_load_lds((const unsigned*)(pb[i] + k0), (LAS unsigned*)(sB + (cur ^ 1) * 16384 + wbase + i * 4096), 16, 0, 0);
        }
      }
      __builtin_amdgcn_s_setprio(1);
#pragma unroll
      for (int ks = 0; ks < 2; ++ks)
#pragma unroll
        for (int mi = 0; mi < 4; ++mi)
#pragma unroll
          for (int ni = 0; ni < 4; ++ni) acc[mi][ni] = mfma16(bfr[ks][ni], af[ks][mi], acc[mi][ni]);
      __builtin_amdgcn_s_setprio(0);
    }
    __syncthreads();
  }
}

__device__ __forceinline__ void acc_to_lds(unsigned char* lds, const f32x4 (&acc)[4][4]) {
  const int tid = threadIdx.x, lane = tid & 63, w = tid >> 6, wm = w >> 1, wn = w & 1, r16 = lane & 15, quad = lane >> 4;
  float* T = (float*)lds;
#pragma unroll
  for (int mi = 0; mi < 4; ++mi)
#pragma unroll
    for (int ni = 0; ni < 4; ++ni) *(f32x4*)(T + (wm * 64 + mi * 16 + r16) * TLD + wn * 64 + ni * 16 + quad * 4) = acc[mi][ni];
}

__device__ __forceinline__ int unit_linear(int u, int G) { const int x = u & 7, v = (u % G) >> 3; return (u / G) * G + x * (G >> 3) + v; }
__device__ __forceinline__ bool unit_decode(int L, int nRT, int nCT, int& rt, int& ct) {
  const int per = 8 * nCT; const int sg = L / per; const int rem = L - sg * per; ct = rem >> 3; rt = sg * 8 + (rem & 7);
  return rt < nRT;
}

__device__ __forceinline__ void transpose_tile(unsigned char* lds, const float* __restrict__ src, int ld_src, int k0, int nsrc0, int nvalid, bf16_t* __restrict__ dst, int ld_dst, int ndst0) {
  float* T = (float*)lds;
  const int tid = threadIdx.x;
  f32x4 v[4];
#pragma unroll
  for (int m = 0; m < 4; ++m) {
    const int q = tid + 256 * m, k = q >> 4, n4 = (q & 15) * 4;
    const float* sp = src + (size_t)(k0 + k) * ld_src + nsrc0 + n4;
    if (n4 + 3 < nvalid) v[m] = *(const f32x4*)sp;
    else { v[m] = (f32x4){0.f, 0.f, 0.f, 0.f};
#pragma unroll
      for (int j = 0; j < 4; ++j) if (n4 + j < nvalid) v[m][j] = sp[j]; }
  }
#pragma unroll
  for (int m = 0; m < 4; ++m) { const int q = tid + 256 * m, k = q >> 4, n4 = (q & 15) * 4; *(f32x4*)(T + k * 68 + n4) = v[m]; }
  __syncthreads();
  const int n = tid >> 2, kseg = (tid & 3) * 16;
  unsigned pk[8];
#pragma unroll
  for (int i = 0; i < 8; ++i) pk[i] = pk_bf16(T[(kseg + 2 * i) * 68 + n], T[(kseg + 2 * i + 1) * 68 + n]);
  bf16_t* d = dst + (size_t)(ndst0 + n) * ld_dst + k0 + kseg;
  *(u32x4*)(d) = (u32x4){pk[0], pk[1], pk[2], pk[3]};
  *(u32x4*)(d + 8) = (u32x4){pk[4], pk[5], pk[6], pk[7]};
  __syncthreads();
}

__device__ __forceinline__ void rstd_rows(const Params& p) {
  const int lane = threadIdx.x & 63; const int gw = (blockIdx.x * 256 + threadIdx.x) >> 6, nw = gridDim.x * 4;
  for (int r = gw; r < MTOT; r += nw) {
    const float* x = (r < MP) ? p.xp + (size_t)r * DM : p.xs + (size_t)(r - MP) * DM;
    float s = 0.f;
#pragma unroll
    for (int m = 0; m < 4; ++m) { const f32x4 v = *(const f32x4*)(x + lane * 4 + 256 * m); s += v[0] * v[0] + v[1] * v[1] + v[2] * v[2] + v[3] * v[3]; }
    s = wave_sum(s);
    if (lane == 0) p.rstd[r] = rsqrtf(s * (1.f / DM) + 1e-6f);
  }
}

__device__ __forceinline__ void phase0(const Params& p, unsigned char* lds) {
  for (int job = blockIdx.x; job < 5600; job += gridDim.x) {
    int j = job;
    if (j < 64) { const int g = j >> 4, t = j & 15, kt = t >> 2, nt = t & 3;
      transpose_tile(lds, p.pool_w + (size_t)g * 65536, 256, kt * 64, nt * 64, 64, p.WpoolT + (size_t)g * 65536, 256, nt * 64); continue; }
    j -= 64;
    if (j < 2816) { const int layer = j / 1408, t = j % 1408, kt = t / 88, nb = t % 88;
      const int ct = nb >> 1, isval = nb & 1; const int nsrc0 = isval ? DFF + ct * 64 : ct * 64;
      transpose_tile(lds, p.ffn_w_up + (size_t)layer * DM * DFF2, DFF2, kt * 64, nsrc0, 64, layer ? p.WupT1 : p.WupT0, DM, nb * 64); continue; }
    j -= 2816;
    if (j < 1408) { const int layer = j / 704, t = j % 704, kt = t / 16, nb = t % 16;
      transpose_tile(lds, p.ffn_w_down + (size_t)layer * DFF * DM, DM, kt * 64, nb * 64, 64, layer ? p.WdnT1 : p.WdnT0, DFF, nb * 64); continue; }
    j -= 1408;
    if (j < 1056) { const int kt = j / 66, nb = j % 66; const int nv = (DNIN - nb * 64) < 0 ? 0 : ((DNIN - nb * 64) > 64 ? 64 : (DNIN - nb * 64));
      transpose_tile(lds, p.dn_w_in, DNIN, kt * 64, nb * 64, nv, p.WinT, DM, nb * 64); continue; }
    j -= 1056;
    { const int kt = j >> 4, nb = j & 15; transpose_tile(lds, p.dn_w_out, DM, kt * 64, nb * 64, 64, p.WoutT, DM, nb * 64); }
  }
  rstd_rows(p);
  const size_t gt = (size_t)blockIdx.x * 256 + threadIdx.x, gn = (size_t)gridDim.x * 256;
  for (size_t i = gt; i < (size_t)MS * 14 * 256; i += gn) {
    const size_t c4 = i & 255, r = (i >> 8) % 14, b = (i >> 8) / 14;
    *(f32x4*)(p.out + O_POOLS + (b * 15 + r) * DM + c4 * 4) = *(const f32x4*)(p.st_pool + (b * 15 + r + 1) * DM + c4 * 4);
  }
  for (size_t i = gt; i < (size_t)MS * 2 * 768; i += gn) {
    const size_t c4 = i % 768, r = (i / 768) & 1, b = i / 1536;
    *(f32x4*)(p.out + O_DNCS + (b * 3 + r) * 3072 + c4 * 4) = *(const f32x4*)(p.st_dnc + (b * 3 + r + 1) * 3072 + c4 * 4);
  }
  for (size_t i = gt; i < (size_t)2 * MS * 1408; i += gn) {
    const size_t c4 = i % 1408, lb = i / 1408;
    *(f32x4*)(p.out + O_FFNS + (lb * 2 + 0) * DFF2 + c4 * 4) = *(const f32x4*)(p.st_ffn + (lb * 2 + 1) * DFF2 + c4 * 4);
  }
}

__device__ __forceinline__ void phase1(const Params& p) {
  const int gt = blockIdx.x * 256 + threadIdx.x, gn = gridDim.x * 256;
  const float* w1 = p.norm1_w;
  for (int idx = gt; idx < 1024 * 256; idx += gn) {
    const int f4 = idx & 255, strip = idx >> 8, b = strip >> 7, t0 = (strip & 127) * 16, c = f4 * 4, g = f4 >> 6, win = 2 << g;
    const f32x4 wv = *(const f32x4*)(w1 + c);
    const float* xb = p.xp + (size_t)b * TSEQ * DM + c; const float* rs = p.rstd + b * TSEQ;
    f32x4 s = (f32x4){0.f, 0.f, 0.f, 0.f};
    for (int j = 1; j < win; ++j) { const int t = t0 - j; if (t >= 0) s += *(const f32x4*)(xb + (size_t)t * DM) * rs[t] * wv; }
    for (int tt = 0; tt < 16; ++tt) {
      const int t = t0 + tt;
      const f32x4 ht = *(const f32x4*)(xb + (size_t)t * DM) * rs[t] * wv;
      s += ht;
      const int cnt = (t + 1 < win) ? (t + 1) : win;
      const f32x4 dgv = s * __builtin_amdgcn_rcpf((float)cnt) - ht;
      *(u32x2*)(p.actA + (size_t)(b * TSEQ + t) * DM + c) = (u32x2){pk_bf16(dgv[0], dgv[1]), pk_bf16(dgv[2], dgv[3])};
      if (t >= TSEQ - 15) *(f32x4*)(p.out + O_POOLP + ((size_t)b * 15 + (t - (TSEQ - 15))) * DM + c) = ht;
      const int to = t - win + 1;
      if (to >= 0) s -= *(const f32x4*)(xb + (size_t)to * DM) * rs[to] * wv;
    }
  }
  for (int idx = gt; idx < MS * 256; idx += gn) {
    const int f4 = idx & 255, b = idx >> 8, c = f4 * 4, g = f4 >> 6, win = 2 << g;
    const f32x4 wv = *(const f32x4*)(w1 + c);
    const f32x4 ht = *(const f32x4*)(p.xs + (size_t)b * DM + c) * p.rstd[MP + b] * wv;
    f32x4 s = ht;
    for (int j = 1; j < win; ++j) s += *(const f32x4*)(p.st_pool + ((size_t)b * 15 + (15 - j)) * DM + c);
    const f32x4 dgv = s * __builtin_amdgcn_rcpf((float)win) - ht;
    *(u32x2*)(p.actA + (size_t)(MP + b) * DM + c) = (u32x2){pk_bf16(dgv[0], dgv[1]), pk_bf16(dgv[2], dgv[3])};
    *(f32x4*)(p.out + O_POOLS + ((size_t)b * 15 + 14) * DM + c) = ht;
  }
}

template <int MODE>
__device__ __forceinline__ void gemm_rows_phase(const Params& p, unsigned char* lds, const bf16_t* A, int lda, const bf16_t* Bt, int K, int ksplit) {
  const int G = gridDim.x, nCT = 8;
  const int nRT = (MODE == 0) ? MTOT / 128 : MP / 128;
  const int nmain = ((nRT + 7) / 8) * 8 * nCT, total = nmain + ((MODE == 0) ? 0 : 8 * ksplit);
  const int tid = threadIdx.x, lane = tid & 63, w = tid >> 6, wm = w >> 1, wn = w & 1, r16 = lane & 15, quad = lane >> 4;
  const int nround = (total + G - 1) / G;
  for (int rd = 0; rd < nround; ++rd) {
    const int L = unit_linear(rd * G + blockIdx.x, G);
    int rt, ct, kofs = 0, klen = K; bool sub = false;
    if (L >= total) continue;
    if (L < nmain) { if (!unit_decode(L, nRT, nCT, rt, ct)) continue; }
    else { const int idx = L - nmain; ct = idx & 7; rt = MP / 128; klen = K / ksplit; kofs = (idx >> 3) * klen; sub = true; }
    int arow[4];
#pragma unroll
    for (int i = 0; i < 4; ++i) arow[i] = rt * 128 + (tid >> 3) + 32 * i;
    f32x4 acc[4][4];
    if (MODE == 0) gemm_mainloop(lds, A, lda, arow, (ct >> 1) * 256, Bt + (size_t)(ct >> 1) * 65536, 256, (ct & 1) * 128, 0, 256, acc);
    else gemm_mainloop(lds, A, lda, arow, kofs, Bt, K, ct * 128, kofs, klen, acc);
#pragma unroll
    for (int mi = 0; mi < 4; ++mi) {
      const int row = rt * 128 + wm * 64 + mi * 16 + r16;
      float* orow = p.out + (size_t)row * DM;
#pragma unroll
      for (int ni = 0; ni < 4; ++ni) {
        const int col = ct * 128 + wn * 64 + ni * 16 + quad * 4;
        if (MODE == 0) {
          const float* xin = (row < MP) ? p.xp + (size_t)row * DM : p.xs + (size_t)(row - MP) * DM;
          *(f32x4*)(orow + col) = *(const f32x4*)(xin + col) + acc[mi][ni] * *(const f32x4*)(p.pool_scale + col);
        } else if (!sub) {
          *(f32x4*)(orow + col) = *(const f32x4*)(orow + col) + acc[mi][ni];
        } else {
#pragma unroll
          for (int j = 0; j < 4; ++j) (void)0;
          *(f32x4*)(p.part + ((size_t)(kofs / klen) * MS + (row - MP)) * DM + col) = acc[mi][ni];
        }
      }
    }
  }
}

__device__ __forceinline__ void norm_load_row(const Params& p, int r, int lane, int npart, f32x4 (&v)[4]) {
  const float* x = p.out + (size_t)r * DM;
#pragma unroll
  for (int m = 0; m < 4; ++m) v[m] = *(const f32x4*)(x + lane * 4 + 256 * m);
  if (r >= MP) {
    const float* part = p.part; asm volatile("" : "+v"(part));
    for (int k = 0; k < npart; ++k)
#pragma unroll
      for (int m = 0; m < 4; ++m) v[m] += *(const f32x4*)(part + ((size_t)k * MS + (r - MP)) * DM + lane * 4 + 256 * m);
  }
}
__device__ __forceinline__ void norm_to_bf16(const Params& p, const float* wgt, int npart) {
  const int lane = threadIdx.x & 63; const int gw = (blockIdx.x * 256 + threadIdx.x) >> 6, nw = gridDim.x * 4;
  f32x4 wv[4];
#pragma unroll
  for (int m = 0; m < 4; ++m) wv[m] = *(const f32x4*)(wgt + lane * 4 + 256 * m);
  f32x4 v[4], vn[4];
  if (gw < MTOT) norm_load_row(p, gw, lane, npart, v);
  for (int r = gw; r < MTOT; r += nw) {
    const bool more = r + nw < MTOT;
    if (more) norm_load_row(p, r + nw, lane, npart, vn);
    float s = 0.f;
#pragma unroll
    for (int m = 0; m < 4; ++m) s += v[m][0] * v[m][0] + v[m][1] * v[m][1] + v[m][2] * v[m][2] + v[m][3] * v[m][3];
    s = wave_sum(s);
    const float rs = rsqrtf(s * (1.f / DM) + 1e-6f);
    if (r >= MP && npart > 0) {
#pragma unroll
      for (int m = 0; m < 4; ++m) *(f32x4*)(p.out + (size_t)r * DM + lane * 4 + 256 * m) = v[m];
    }
#pragma unroll
    for (int m = 0; m < 4; ++m) { const f32x4 o = v[m] * rs * wv[m];
      *(u32x2*)(p.actA + (size_t)r * DM + lane * 4 + 256 * m) = (u32x2){pk_bf16(o[0], o[1]), pk_bf16(o[2], o[3])}; }
    if (more) {
#pragma unroll
      for (int m = 0; m < 4; ++m) v[m] = vn[m];
    }
  }
}
__device__ __forceinline__ void final_norm(const Params& p, int npart) {
  const int lane = threadIdx.x & 63; const int gw = (blockIdx.x * 256 + threadIdx.x) >> 6, nw = gridDim.x * 4;
  f32x4 wv[4];
#pragma unroll
  for (int m = 0; m < 4; ++m) wv[m] = *(const f32x4*)(p.final_w + lane * 4 + 256 * m);
  f32x4 v[4], vn[4];
  if (gw < MTOT) norm_load_row(p, gw, lane, npart, v);
  for (int r = gw; r < MTOT; r += nw) {
    const bool more = r + nw < MTOT;
    if (more) norm_load_row(p, r + nw, lane, npart, vn);
    float s = 0.f;
#pragma unroll
    for (int m = 0; m < 4; ++m) s += v[m][0] * v[m][0] + v[m][1] * v[m][1] + v[m][2] * v[m][2] + v[m][3] * v[m][3];
    s = wave_sum(s);
    const float rs = rsqrtf(s * (1.f / DM) + 1e-6f);
#pragma unroll
    for (int m = 0; m < 4; ++m) *(f32x4*)(p.out + (size_t)r * DM + lane * 4 + 256 * m) = v[m] * rs * wv[m];
    if (more) {
#pragma unroll
      for (int m = 0; m < 4; ++m) v[m] = vn[m];
    }
  }
}

__device__ __forceinline__ void ffn_up_phase(const Params& p, unsigned char* lds, int layer) {
  const int G = gridDim.x, nRT = NBP * 17 + 1, nCT = 44, total = ((nRT + 7) / 8) * 8 * nCT;
  const int tid = threadIdx.x;
  const bf16_t* Bt = layer ? p.WupT1 : p.WupT0;
  const float* cw = p.ffn_conv_w + (size_t)layer * 3 * DFF2; const float* cb = p.ffn_conv_b + (size_t)layer * DFF2;
  const int nround = (total + G - 1) / G;
  for (int rd = 0; rd < nround; ++rd) {
    const int L = unit_linear(rd * G + blockIdx.x, G);
    int rt, ct;
    if (L >= total || !unit_decode(L, nRT, nCT, rt, ct)) continue;
    const bool samp = (rt == NBP * 17);
    const int b = rt / 17, ti = rt % 17, tbase = 126 * ti - 2;
    int arow[4];
#pragma unroll
    for (int i = 0; i < 4; ++i) { const int l = (tid >> 3) + 32 * i; int t = tbase + l; t = t < 0 ? 0 : (t > TSEQ - 1 ? TSEQ - 1 : t); arow[i] = samp ? MP + l : b * TSEQ + t; }
    f32x4 acc[4][4];
    gemm_mainloop(lds, p.actA, DM, arow, 0, Bt, DM, ct * 128, 0, DM, acc);
    acc_to_lds(lds, acc);
    __syncthreads();
    const float* T = (const float*)lds;
    const int cc = tid & 63, strip = tid >> 6, l0 = strip * 32;
    const int gcol = ct * 64 + cc, vcol = DFF + ct * 64 + cc;
    const float wg0 = cw[gcol], wg1 = cw[DFF2 + gcol], wg2 = cw[2 * DFF2 + gcol], bg = cb[gcol];
    const float wv0 = cw[vcol], wv1 = cw[DFF2 + vcol], wv2 = cw[2 * DFF2 + vcol], bv = cb[vcol];
    if (!samp) {
      const int c2 = (tid & 31) * 2, l0b = (tid >> 5) * 16, ls = l0b < 2 ? 2 : l0b;
      const int gc2 = ct * 64 + c2, vc2 = DFF + ct * 64 + c2;
      typedef float f32x2v __attribute__((ext_vector_type(2)));
      const f32x2v Wg0 = *(const f32x2v*)(cw + gc2), Wg1 = *(const f32x2v*)(cw + DFF2 + gc2), Wg2 = *(const f32x2v*)(cw + 2 * DFF2 + gc2), Bg = *(const f32x2v*)(cb + gc2);
      const f32x2v Wv0 = *(const f32x2v*)(cw + vc2), Wv1 = *(const f32x2v*)(cw + DFF2 + vc2), Wv2 = *(const f32x2v*)(cw + 2 * DFF2 + vc2), Bv = *(const f32x2v*)(cb + vc2);
      f32x2v G2 = *(const f32x2v*)(T + (ls - 2) * TLD + c2), G1 = *(const f32x2v*)(T + (ls - 1) * TLD + c2);
      f32x2v V2 = *(const f32x2v*)(T + (ls - 2) * TLD + 64 + c2), V1 = *(const f32x2v*)(T + (ls - 1) * TLD + 64 + c2);
      if (tbase + ls - 2 < 0) { G2 = (f32x2v){0.f, 0.f}; V2 = G2; }
      if (tbase + ls - 1 < 0) { G1 = (f32x2v){0.f, 0.f}; V1 = G1; }
      for (int l = ls; l < l0b + 16; ++l) {
        const int t = tbase + l; if (t >= TSEQ) break;
        const f32x2v G0 = *(const f32x2v*)(T + l * TLD + c2), V0 = *(const f32x2v*)(T + l * TLD + 64 + c2);
        const f32x2v cg = G2 * Wg0 + G1 * Wg1 + G0 * Wg2 + Bg, cv = V2 * Wv0 + V1 * Wv1 + V0 * Wv2 + Bv;
        *(unsigned*)(p.act + (size_t)(b * TSEQ + t) * DFF + ct * 64 + c2) = pk_bf16(silu_f(cg[0]) * cv[0], silu_f(cg[1]) * cv[1]);
        if (t >= TSEQ - 2) { float* o = p.out + O_FFNP + ((size_t)(layer * NBP + b) * 2 + (t - (TSEQ - 2))) * DFF2; *(f32x2v*)(o + gc2) = G0; *(f32x2v*)(o + vc2) = V0; }
        G2 = G1; G1 = G0; V2 = V1; V1 = V0;
      }
    } else {
      for (int l = l0; l < l0 + 32; ++l) {
        const float g0 = T[l * TLD + cc], v0 = T[l * TLD + 64 + cc];
        const float* st = p.st_ffn + (size_t)(layer * MS + l) * 2 * DFF2;
        const float cgt = st[gcol] * wg0 + st[DFF2 + gcol] * wg1 + g0 * wg2 + bg, cvl = st[vcol] * wv0 + st[DFF2 + vcol] * wv1 + v0 * wv2 + bv;
        p.act[(size_t)(MP + l) * DFF + ct * 64 + cc] = f2bf(silu_f(cgt) * cvl);
        float* o = p.out + O_FFNS + ((size_t)(layer * MS + l) * 2 + 1) * DFF2; o[gcol] = g0; o[vcol] = v0;
      }
    }
    __syncthreads();
  }
}

__device__ __forceinline__ void dn_in_phase(const Params& p, unsigned char* lds) {
  const int G = gridDim.x, nRT = NBP * 17 + 1, nCT = 33, total = ((nRT + 7) / 8) * 8 * nCT;
  const int tid = threadIdx.x, lane = tid & 63, w = tid >> 6;
  const int nround = (total + G - 1) / G;
  for (int rd = 0; rd < nround; ++rd) {
    const int L = unit_linear(rd * G + blockIdx.x, G);
    int rt, ct;
    if (L >= total || !unit_decode(L, nRT, nCT, rt, ct)) continue;
    const bool samp = (rt == NBP * 17);
    const int b = rt / 17, ti = rt % 17, tbase = 125 * ti - 3;
    int arow[4];
#pragma unroll
    for (int i = 0; i < 4; ++i) { const int l = (tid >> 3) + 32 * i; int t = tbase + l; t = t < 0 ? 0 : (t > TSEQ - 1 ? TSEQ - 1 : t); arow[i] = samp ? MP + l : b * TSEQ + t; }
    f32x4 acc[4][4];
    gemm_mainloop(lds, p.actA, DM, arow, 0, p.WinT, DM, ct * 128, 0, DM, acc);
    acc_to_lds(lds, acc);
    __syncthreads();
    const float* T = (const float*)lds;
    const int l0 = w * 32;
    if (ct < 24) {
      const int c0 = lane * 2, c1 = lane * 2 + 1, col0 = ct * 128 + c0, col1 = ct * 128 + c1;
      const float* cw = p.dn_conv_w;
      const float a0 = cw[col0], a1 = cw[3072 + col0], a2 = cw[2 * 3072 + col0], a3 = cw[3 * 3072 + col0];
      const float e0 = cw[col1], e1 = cw[3072 + col1], e2 = cw[2 * 3072 + col1], e3 = cw[3 * 3072 + col1];
      bf16_t* dst = (ct < 8) ? p.qb : (ct < 16 ? p.kb : p.vb);
      const int hc = (ct & 7) * 128;
      const float post = (ct < 8) ? 0.08838834764831845f : 1.f;
      if (!samp) {
        const int ls = l0 < 3 ? 3 : l0;
        float x3 = T[(ls - 3) * TLD + c0], x2 = T[(ls - 2) * TLD + c0], x1 = T[(ls - 1) * TLD + c0];
        float y3 = T[(ls - 3) * TLD + c1], y2 = T[(ls - 2) * TLD + c1], y1 = T[(ls - 1) * TLD + c1];
        if (tbase + ls - 3 < 0) { x3 = 0.f; y3 = 0.f; }
        if (tbase + ls - 2 < 0) { x2 = 0.f; y2 = 0.f; }
        if (tbase + ls - 1 < 0) { x1 = 0.f; y1 = 0.f; }
        for (int l = ls; l < l0 + 32; ++l) {
          const int t = tbase + l; if (t >= TSEQ) break;
          const float x0 = T[l * TLD + c0], y0 = T[l * TLD + c1];
          float s0 = silu_f(x3 * a0 + x2 * a1 + x1 * a2 + x0 * a3), s1 = silu_f(y3 * e0 + y2 * e1 + y1 * e2 + y0 * e3);
          if (ct < 16) { const float ss = wave_sum(s0 * s0 + s1 * s1); const float sc = rsqrtf(ss + 1e-6f) * post; s0 *= sc; s1 *= sc; }
          bf16_t* d = dst + (size_t)(b * TSEQ + t) * DM + hc;
          *(unsigned*)(d + c0) = pk_bf16(s0, s1);
          if (t >= TSEQ - 3) { float* o = p.out + O_DNCP + ((size_t)b * 3 + (t - (TSEQ - 3))) * 3072; *(f32x2*)(o + col0) = (f32x2){x0, y0}; }
          x3 = x2; x2 = x1; x1 = x0; y3 = y2; y2 = y1; y1 = y0;
        }
      } else {
        for (int l = l0; l < l0 + 32; ++l) {
          const float x0 = T[l * TLD + c0], y0 = T[l * TLD + c1];
          const float* st = p.st_dnc + (size_t)l * 3 * 3072;
          float s0 = silu_f(st[col0] * a0 + st[3072 + col0] * a1 + st[2 * 3072 + col0] * a2 + x0 * a3);
          float s1 = silu_f(st[col1] * e0 + st[3072 + col1] * e1 + st[2 * 3072 + col1] * e2 + y0 * e3);
          if (ct < 16) { const float ss = wave_sum(s0 * s0 + s1 * s1); const float sc = rsqrtf(ss + 1e-6f) * post; s0 *= sc; s1 *= sc; }
          bf16_t* d = dst + (size_t)(MP + l) * DM + hc;
          *(unsigned*)(d + c0) = pk_bf16(s0, s1);
          float* o = p.out + O_DNCS + ((size_t)l * 3 + 2) * 3072; *(f32x2*)(o + col0) = (f32x2){x0, y0};
        }
      }
    } else if (ct < 32) {
      const int hc = (ct - 24) * 128;
      for (int l = l0; l < l0 + 32; ++l) {
        int row;
        if (samp) row = MP + l; else { const int t = tbase + l; if (l < 3 || t >= TSEQ) continue; row = b * TSEQ + t; }
        bf16_t* d = p.zb + (size_t)row * DM + hc;
        *(unsigned*)(d + 2 * lane) = pk_bf16(T[l * TLD + 2 * lane], T[l * TLD + 2 * lane + 1]);
      }
    } else {
      const int l = tid & 127, part = tid >> 7;
      int row = -1;
      if (samp) row = MP + l; else { const int t = tbase + l; if (l >= 3 && t < TSEQ) row = b * TSEQ + t; }
      if (row >= 0) {
#pragma unroll
        for (int hh = 0; hh < 8; ++hh) {
          if (part == 0) { const float a = T[l * TLD + hh] + p.dn_dt_bias[hh]; const float sp = (a > 0.f ? a : 0.f) + log1pf(__expf(-fabsf(a)));
            p.gbuf[(size_t)row * 8 + hh] = -__expf(p.dn_a_log[hh]) * sp; }
          else { const float bb = T[l * TLD + 8 + hh]; p.betabuf[(size_t)row * 8 + hh] = __builtin_amdgcn_rcpf(1.f + __expf(-bb)); }
        }
      }
    }
    __syncthreads();
  }
}

__device__ __forceinline__ unsigned img256(int row, int c) { return (unsigned)(row * 256 + ((((c >> 3) ^ (row & 15))) << 4) + (c & 7) * 2); }
__device__ __forceinline__ unsigned img128(int row, int c) { return (unsigned)(row * 128 + ((((c >> 3) ^ ((row >> 1) & 7))) << 4) + (c & 7) * 2); }

__device__ __forceinline__ void dn_chunk_item(const Params& p, unsigned char* lds, int item) {
  const int tid = threadIdx.x, lane = tid & 63, w = tid >> 6, r16 = lane & 15, quad = lane >> 4;
  const int h = item & 7, n = (item >> 3) & 31, b = item >> 8;
  const int r0 = b * TSEQ + n * 64;
  unsigned char* kimg = lds; unsigned char* qimg = lds + 16384; unsigned char* vimg = lds + 32768;
  unsigned char* Lbf = lds + 49152;
  float* Ld = (float*)(lds + 49152 + 8192);
  float* gcs = (float*)(lds + 49152 + 17408);
  float* egs = gcs + 64; float* bts = egs + 64;
  if (tid < 64) {
    float val = p.gbuf[(size_t)(r0 + tid) * 8 + h];
#pragma unroll
    for (int off = 1; off < 64; off <<= 1) { const float t = __shfl_up(val, off); if (lane >= off) val += t; }
    gcs[tid] = val; egs[tid] = __expf(val); bts[tid] = p.betabuf[(size_t)(r0 + tid) * 8 + h];
    p.gcbuf[(size_t)item * 64 + tid] = val;
  }
  {
    const int ch = tid & 15;
#pragma unroll
    for (int i = 0; i < 4; ++i) {
      const int row = (tid >> 4) + 16 * i; const size_t go = (size_t)(r0 + row) * DM + h * 128 + ch * 8; const unsigned lo = row * 256 + ((ch ^ (row & 15)) << 4);
      *(u32x4*)(kimg + lo) = *(const u32x4*)(p.kb + go); *(u32x4*)(qimg + lo) = *(const u32x4*)(p.qb + go); *(u32x4*)(vimg + lo) = *(const u32x4*)(p.vb + go);
    }
  }
  __syncthreads();
  {
#pragma unroll
    for (int nt = 0; nt < 4; ++nt) {
      f32x4 ck = (f32x4){0.f, 0.f, 0.f, 0.f}, cq = ck;
      if (nt <= w) {
#pragma unroll
        for (int ks = 0; ks < 4; ++ks) {
          const unsigned o = (16 * w + r16) * 256 + (((ks * 4 + quad) ^ r16) << 4);
          const bf16x8 ak = *(const bf16x8*)(kimg + o), aq = *(const bf16x8*)(qimg + o);
          const bf16x8 bk = *(const bf16x8*)(kimg + (16 * nt + r16) * 256 + (((ks * 4 + quad) ^ r16) << 4)); ck = mfma16(ak, bk, ck); cq = mfma16(aq, bk, cq); }
      }
      const int jc = 16 * nt + r16; const float gj = gcs[jc];
#pragma unroll
      for (int jj = 0; jj < 4; ++jj) {
        const int i = 16 * w + quad * 4 + jj;
        const float dec = (jc <= i) ? __expf(gcs[i] - gj) : 0.f;
        const float Lv = (jc < i) ? bts[i] * ck[jj] * dec : 0.f;
        if (nt == w) Ld[(w * 16 + quad * 4 + jj) * 16 + r16] = Lv;
        *(bf16_t*)(Lbf + img128(i, jc)) = (nt < w) ? f2bf(Lv) : (bf16_t)0;
        p.qkb[(size_t)item * 4096 + i * 64 + jc] = f2bf(cq[jj] * dec);
      }
    }
  }
  __syncthreads();
  {
    const int ch = tid & 15;
#pragma unroll
    for (int i = 0; i < 4; ++i) {
      const int row = (tid >> 4) + 16 * i; const float e = egs[row];
      const u32x4 qv = *(const u32x4*)(qimg + row * 256 + ((ch ^ (row & 15)) << 4));
      u32x4 o;
#pragma unroll
      for (int j = 0; j < 4; ++j) o[j] = pk_bf16(__uint_as_float(qv[j] << 16) * e, __uint_as_float(qv[j] & 0xffff0000u) * e);
      *(u32x4*)(p.qb + (size_t)(r0 + row) * DM + h * 128 + ch * 8) = o;
    }
    const int i = tid & 63; const float e = __expf(gcs[63] - gcs[i]);
#pragma unroll 4
    for (int m = 0; m < 32; ++m) {
      const int d = (tid >> 6) + 4 * m;
      const float kv = bf2f(*(const bf16_t*)(kimg + img256(i, d)));
      p.vb[(size_t)(r0 + (d >> 1)) * DM + h * 128 + (d & 1) * 64 + i] = f2bf(kv * e);
    }
  }
  {
    const int c = tid; const bool isv = c < 128; const int cl = c & 127;
    unsigned char* XT = lds + 16384;
    float* RT = (float*)lds;
    const int sw_ = (c >> 1) & 7;
    __syncthreads();
    if (isv) {
#pragma unroll
      for (int j8 = 0; j8 < 8; ++j8) {
        float t[8];
#pragma unroll
        for (int j = 0; j < 8; ++j) { const int i = j8 * 8 + j; t[j] = bts[i] * bf2f(*(const bf16_t*)(vimg + img256(i, cl))); }
        *(u32x4*)(XT + c * 128 + ((j8 ^ sw_) << 4)) = (u32x4){pk_bf16(t[0], t[1]), pk_bf16(t[2], t[3]), pk_bf16(t[4], t[5]), pk_bf16(t[6], t[7])};
      }
    }
    __syncthreads();
    if (!isv) {
#pragma unroll
      for (int j8 = 0; j8 < 8; ++j8) {
        float t[8];
#pragma unroll
        for (int j = 0; j < 8; ++j) { const int i = j8 * 8 + j; t[j] = bts[i] * egs[i] * bf2f(*(const bf16_t*)(kimg + img256(i, cl))); }
        *(u32x4*)(XT + c * 128 + ((j8 ^ sw_) << 4)) = (u32x4){pk_bf16(t[0], t[1]), pk_bf16(t[2], t[3]), pk_bf16(t[4], t[5]), pk_bf16(t[6], t[7])};
      }
    }
    __syncthreads();
#pragma unroll 1
    for (int r = 0; r < 4; ++r) {
      float xb[16];
      { const u32x4 lo = *(const u32x4*)(XT + c * 128 + (((2 * r) ^ sw_) << 4)), hi = *(const u32x4*)(XT + c * 128 + (((2 * r + 1) ^ sw_) << 4));
#pragma unroll
        for (int j = 0; j < 4; ++j) { xb[2 * j] = __uint_as_float(lo[j] << 16); xb[2 * j + 1] = __uint_as_float(lo[j] & 0xffff0000u); xb[8 + 2 * j] = __uint_as_float(hi[j] << 16); xb[8 + 2 * j + 1] = __uint_as_float(hi[j] & 0xffff0000u); } }
      if (r > 0) {
#pragma unroll
        for (int nt = 0; nt < 4; ++nt) {
          f32x4 accu = (f32x4){0.f, 0.f, 0.f, 0.f};
          const int ar = 16 * r + r16, br = 64 * w + 16 * nt + r16;
#pragma unroll
          for (int ks = 0; ks < 2; ++ks) {
            const bf16x8 av = *(const bf16x8*)(Lbf + ar * 128 + (((ks * 4 + quad) ^ ((ar >> 1) & 7)) << 4));
            const bf16x8 bv = *(const bf16x8*)(XT + br * 128 + (((ks * 4 + quad) ^ ((br >> 1) & 7)) << 4));
            accu = mfma16(av, bv, accu);
          }
          *(f32x4*)(RT + br * 16 + quad * 4) = accu;
        }
#pragma unroll
        for (int q4 = 0; q4 < 4; ++q4) { const f32x4 t = *(const f32x4*)(RT + c * 16 + q4 * 4); xb[q4 * 4] -= t[0]; xb[q4 * 4 + 1] -= t[1]; xb[q4 * 4 + 2] -= t[2]; xb[q4 * 4 + 3] -= t[3]; }
      }
#pragma unroll
      for (int i = 1; i < 16; ++i) {
        const float lrow = Ld[(r * 16 + i) * 16 + (lane & 15)];
        float a = xb[i];
#pragma unroll
        for (int j = 0; j < i; ++j) a -= __builtin_bit_cast(float, __builtin_amdgcn_readlane(__builtin_bit_cast(int, lrow), j)) * xb[j];
        xb[i] = a;
      }
      *(u32x4*)(XT + c * 128 + (((2 * r) ^ sw_) << 4)) = (u32x4){pk_bf16(xb[0], xb[1]), pk_bf16(xb[2], xb[3]), pk_bf16(xb[4], xb[5]), pk_bf16(xb[6], xb[7])};
      *(u32x4*)(XT + c * 128 + (((2 * r + 1) ^ sw_) << 4)) = (u32x4){pk_bf16(xb[8], xb[9]), pk_bf16(xb[10], xb[11]), pk_bf16(xb[12], xb[13]), pk_bf16(xb[14], xb[15])};
    }
    int item_o = item; asm volatile("" : "+s"(item_o));
    if (isv) {
      bf16_t* d = p.uT + ((size_t)item_o * 128 + cl) * 64;
#pragma unroll
      for (int j8 = 0; j8 < 8; ++j8) *(u32x4*)(d + j8 * 8) = *(const u32x4*)(XT + c * 128 + ((j8 ^ sw_) << 4));
    } else {
      bf16_t* d = p.win + (size_t)item_o * 8192 + cl;
#pragma unroll
      for (int j8 = 0; j8 < 8; ++j8) {
        const u32x4 v8 = *(const u32x4*)(XT + c * 128 + ((j8 ^ sw_) << 4));
#pragma unroll
        for (int j = 0; j < 4; ++j) { d[(j8 * 8 + 2 * j) * 128] = (bf16_t)(v8[j] & 0xffffu); d[(j8 * 8 + 2 * j + 1) * 128] = (bf16_t)(v8[j] >> 16); }
      }
    }
  }
  __syncthreads();
}

__device__ __forceinline__ void dn_sample_item(const Params& p, unsigned char* lds, int item) {
  const int tid = threadIdx.x, h = item & 7, b = item >> 3, v4 = (tid & 31) * 4, kq = tid >> 5, k0 = kq * 16;
  float* qf = (float*)lds; float* kf = qf + 128; float* red = kf + 128;
  const size_t row = (size_t)(MP + b);
  if (tid < 128) qf[tid] = bf2f(p.qb[row * DM + h * 128 + tid]); else kf[tid - 128] = bf2f(p.kb[row * DM + h * 128 + tid - 128]);
  const float eg = __expf(p.gbuf[row * 8 + h]), beta = p.betabuf[row * 8 + h];
  const u32x2 vraw = *(const u32x2*)(p.vb + row * DM + h * 128 + v4);
  const f32x4 vv = (f32x4){__uint_as_float(vraw[0] << 16), __uint_as_float(vraw[0] & 0xffff0000u), __uint_as_float(vraw[1] << 16), __uint_as_float(vraw[1] & 0xffff0000u)};
  const float* S = p.st_ssm + ((size_t)(b * 8 + h) * 128 + k0) * 128 + v4;
  f32x4 s[16];
#pragma unroll
  for (int k = 0; k < 16; ++k) s[k] = *(const f32x4*)(S + (size_t)k * 128);
  __syncthreads();
  f32x4 ks = (f32x4){0.f, 0.f, 0.f, 0.f}, qs = ks; float qk = 0.f;
#pragma unroll
  for (int k = 0; k < 16; ++k) { ks += s[k] * kf[k0 + k]; qs += s[k] * qf[k0 + k]; }
#pragma unroll 8
  for (int k = 0; k < 128; ++k) qk += qf[k] * kf[k];
  *(f32x4*)(red + kq * 256 + v4) = ks; *(f32x4*)(red + kq * 256 + 128 + v4) = qs;
  __syncthreads();
  f32x4 kst = (f32x4){0.f, 0.f, 0.f, 0.f}, qst = kst;
#pragma unroll
  for (int g = 0; g < 8; ++g) { kst += *(const f32x4*)(red + g * 256 + v4); qst += *(const f32x4*)(red + g * 256 + 128 + v4); }
  const f32x4 u = (vv - kst * eg) * beta;
  if (kq == 0) *(f32x4*)(p.osamp + (size_t)b * DM + h * 128 + v4) = qst * eg + u * qk;
  float* So = p.out + O_DNSS + ((size_t)(b * 8 + h) * 128 + k0) * 128 + v4;
#pragma unroll
  for (int k = 0; k < 16; ++k) *(f32x4*)(So + (size_t)k * 128) = s[k] * eg + u * kf[k0 + k];
  __syncthreads();
}

__device__ __forceinline__ void dn_pre_phase(const Params& p, unsigned char* lds) {
  for (int it = blockIdx.x; it < 2048; it += gridDim.x) dn_chunk_item(p, lds, it);
  for (int it = blockIdx.x; it < 1024; it += gridDim.x) dn_sample_item(p, lds, it);
}

__device__ __forceinline__ void dn_scan_phase(const Params& p, unsigned char* lds) {
  if (blockIdx.x >= 256) return;
  const int tid = threadIdx.x, lane = tid & 63, w = tid >> 6, r16 = lane & 15, quad = lane >> 4;
  const int xcd = blockIdx.x & 7, slot = blockIdx.x >> 3; const int pair = xcd * 8 + (slot >> 2), vs = slot & 3;
  const int b = pair >> 3, h = pair & 7;
  unsigned char* Wimg = lds; unsigned char* Qimg = lds + 16384; unsigned char* KTimg = lds + 32768; unsigned char* QKimg = lds + 49152;
  unsigned char* STimg = lds + 57344; unsigned char* UTimg = lds + 65536;
  for (int i = tid; i < 8192 / 16; i += 256) *(u32x4*)(STimg + i * 16) = (u32x4){0u, 0u, 0u, 0u};
  f32x4 accS[2][2];
#pragma unroll
  for (int a = 0; a < 2; ++a)
#pragma unroll
    for (int c = 0; c < 2; ++c) accS[a][c] = (f32x4){0.f, 0.f, 0.f, 0.f};
  u32x4 rw[4], rq[4], rk[4], rqk[2]; u32x2 ruc[2]; float gl_next;
  auto prefetch = [&](int n) {
    const int item = (b * 32 + n) * 8 + h; const int r0 = b * TSEQ + n * 64;
#pragma unroll
    for (int i = 0; i < 4; ++i) {
      const int q = tid + 256 * i;
      { const int row = q >> 4, ch = q & 15; rw[i] = *(const u32x4*)(p.win + (size_t)item * 8192 + row * 128 + ch * 8); rq[i] = *(const u32x4*)(p.qb + (size_t)(r0 + row) * DM + h * 128 + ch * 8); }
      { const int kidx = q >> 3, ch = q & 7; rk[i] = *(const u32x4*)(p.vb + (size_t)(r0 + (kidx >> 1)) * DM + h * 128 + (kidx & 1) * 64 + ch * 8); }
    }
#pragma unroll
    for (int i = 0; i < 2; ++i) { const int q = tid + 256 * i; const int row = q >> 3, ch = q & 7; rqk[i] = *(const u32x4*)(p.qkb + (size_t)item * 4096 + row * 64 + ch * 8); }
#pragma unroll
    for (int nt = 0; nt < 2; ++nt) ruc[nt] = *(const u32x2*)(p.uT + ((size_t)item * 128 + vs * 32 + nt * 16 + r16) * 64 + 16 * w + quad * 4);
    gl_next = p.gcbuf[(size_t)item * 64 + 63];
  };
  prefetch(0);
  for (int n = 0; n < 32; ++n) {
    const int item = (b * 32 + n) * 8 + h;
#pragma unroll
    for (int i = 0; i < 4; ++i) {
      const int q = tid + 256 * i;
      { const int row = q >> 4, ch = q & 15; const unsigned lo = row * 256 + ((ch ^ (row & 15)) << 4); *(u32x4*)(Wimg + lo) = rw[i]; *(u32x4*)(Qimg + lo) = rq[i]; }
      { const int kidx = q >> 3, ch = q & 7; *(u32x4*)(KTimg + kidx * 128 + ((ch ^ ((kidx >> 1) & 7)) << 4)) = rk[i]; }
    }
#pragma unroll
    for (int i = 0; i < 2; ++i) { const int q = tid + 256 * i; const int row = q >> 3, ch = q & 7; *(u32x4*)(QKimg + row * 128 + ((ch ^ ((row >> 1) & 7)) << 4)) = rqk[i]; }
    u32x2 uc[2] = {ruc[0], ruc[1]};
    const float egl = __expf(gl_next);
    __syncthreads();
    if (n + 1 < 32) prefetch(n + 1);
    f32x4 aWS[2], aQS[2];
#pragma unroll
    for (int nt = 0; nt < 2; ++nt) { aWS[nt] = (f32x4){0.f, 0.f, 0.f, 0.f}; aQS[nt] = aWS[nt]; }
#pragma unroll
    for (int ks = 0; ks < 4; ++ks) {
      const unsigned ao = (16 * w + r16) * 256 + (((ks * 4 + quad) ^ r16) << 4);
      const bf16x8 aw = *(const bf16x8*)(Wimg + ao), aq = *(const bf16x8*)(Qimg + ao);
#pragma unroll
      for (int nt = 0; nt < 2; ++nt) {
        const bf16x8 bs = *(const bf16x8*)(STimg + (nt * 16 + r16) * 256 + (((ks * 4 + quad) ^ r16) << 4));
        aWS[nt] = mfma16(aw, bs, aWS[nt]); aQS[nt] = mfma16(aq, bs, aQS[nt]);
      }
    }
#pragma unroll
    for (int nt = 0; nt < 2; ++nt) {
      const float u0 = __uint_as_float(uc[nt][0] << 16) - aWS[nt][0], u1 = __uint_as_float(uc[nt][0] & 0xffff0000u) - aWS[nt][1];
      const float u2 = __uint_as_float(uc[nt][1] << 16) - aWS[nt][2], u3 = __uint_as_float(uc[nt][1] & 0xffff0000u) - aWS[nt][3];
      const int v = nt * 16 + r16; const int chunk = 2 * w + (quad >> 1);
      *(u32x2*)(UTimg + v * 128 + ((chunk ^ ((v >> 1) & 7)) << 4) + (quad & 1) * 8) = (u32x2){pk_bf16(u0, u1), pk_bf16(u2, u3)};
    }
    __syncthreads();
    bf16x8 bu[2][2];
#pragma unroll
    for (int nt = 0; nt < 2; ++nt)
#pragma unroll
      for (int ks = 0; ks < 2; ++ks) { const int v = nt * 16 + r16; bu[nt][ks] = *(const bf16x8*)(UTimg + v * 128 + (((ks * 4 + quad) ^ ((v >> 1) & 7)) << 4)); }
#pragma unroll
    for (int ks = 0; ks < 2; ++ks) {
      const int row = 16 * w + r16;
      const bf16x8 aqk = *(const bf16x8*)(QKimg + row * 128 + (((ks * 4 + quad) ^ ((row >> 1) & 7)) << 4));
#pragma unroll
      for (int nt = 0; nt < 2; ++nt) aQS[nt] = mfma16(aqk, bu[nt][ks], aQS[nt]);
    }
#pragma unroll
    for (int nt = 0; nt < 2; ++nt)
      *(u32x2*)(p.uT + ((size_t)item * 128 + vs * 32 + nt * 16 + r16) * 64 + 16 * w + quad * 4) = (u32x2){pk_bf16(aQS[nt][0], aQS[nt][1]), pk_bf16(aQS[nt][2], aQS[nt][3])};
#pragma unroll
    for (int mt2 = 0; mt2 < 2; ++mt2) {
      const int mt = 2 * w + mt2; const int kidx = mt * 16 + r16;
#pragma unroll
      for (int nt = 0; nt < 2; ++nt) accS[mt2][nt] = accS[mt2][nt] * egl;
#pragma unroll
      for (int ks = 0; ks < 2; ++ks) {
        const bf16x8 akd = *(const bf16x8*)(KTimg + kidx * 128 + (((ks * 4 + quad) ^ ((kidx >> 1) & 7)) << 4));
#pragma unroll
        for (int nt = 0; nt < 2; ++nt) accS[mt2][nt] = mfma16(akd, bu[nt][ks], accS[mt2][nt]);
      }
#pragma unroll
      for (int nt = 0; nt < 2; ++nt) {
        const int v = nt * 16 + r16; const int chunk = 2 * mt + (quad >> 1);
        *(u32x2*)(STimg + v * 256 + ((chunk ^ (v & 15)) << 4) + (quad & 1) * 8) = (u32x2){pk_bf16(accS[mt2][nt][0], accS[mt2][nt][1]), pk_bf16(accS[mt2][nt][2], accS[mt2][nt][3])};
      }
    }
    __syncthreads();
  }
#pragma unroll
  for (int mt2 = 0; mt2 < 2; ++mt2)
#pragma unroll
    for (int nt = 0; nt < 2; ++nt)
#pragma unroll
      for (int jj = 0; jj < 4; ++jj) {
        const int kidx = (2 * w + mt2) * 16 + quad * 4 + jj, v = vs * 32 + nt * 16 + r16;
        p.out[O_DNSP + ((size_t)(b * 8 + h) * 128 + kidx) * 128 + v] = accS[mt2][nt][jj];
      }
}

__device__ __forceinline__ void dn_onorm_phase(const Params& p, unsigned char* lds) {
  const int tid = threadIdx.x;
  bf16_t* Ot = (bf16_t*)lds;
  float* red = (float*)(lds + 128 * 66 * 2);
  for (int it = blockIdx.x; it < 2048 + 128; it += gridDim.x) {
    if (it < 2048) {
      const int item = it, h = item & 7, n = (item >> 3) & 31, b = item >> 8, r0 = b * TSEQ + n * 64;
#pragma unroll
      for (int i = 0; i < 4; ++i) {
        const int q = tid + 256 * i, v = q >> 3, ch = q & 7;
        const u32x4 d = *(const u32x4*)(p.uT + (size_t)item * 8192 + v * 64 + ch * 8);
        unsigned* dst = (unsigned*)(Ot + v * 66 + ch * 8);
        dst[0] = d[0]; dst[1] = d[1]; dst[2] = d[2]; dst[3] = d[3];
      }
      __syncthreads();
      { const int i = tid & 63, vq = tid >> 6; float s = 0.f;
#pragma unroll 8
        for (int v = vq * 32; v < vq * 32 + 32; ++v) { const float o = bf2f(Ot[v * 66 + i]); s += o * o; }
        red[vq * 64 + i] = s; }
      __syncthreads();
      {
#pragma unroll
        for (int m = 0; m < 4; ++m) {
          const int q = tid + 256 * m, i = q >> 4, v8 = (q & 15) * 8;
          const float rs = rsqrtf((red[i] + red[64 + i] + red[128 + i] + red[192 + i]) * (1.f / 128.f) + 1e-6f);
          const size_t go = (size_t)(r0 + i) * DM + h * 128 + v8;
          const u32x4 zz = *(const u32x4*)(p.zb + go);
          const f32x4 w0 = *(const f32x4*)(p.dn_o_norm_w + v8), w1 = *(const f32x4*)(p.dn_o_norm_w + v8 + 4);
          float r[8];
#pragma unroll
          for (int j = 0; j < 8; ++j) {
            const float z = (j & 1) ? __uint_as_float(zz[j >> 1] & 0xffff0000u) : __uint_as_float(zz[j >> 1] << 16);
            r[j] = bf2f(Ot[(v8 + j) * 66 + i]) * rs * (j < 4 ? w0[j & 3] : w1[j & 3]) * silu_f(z);
          }
          *(u32x4*)(p.actA + go) = (u32x4){pk_bf16(r[0], r[1]), pk_bf16(r[2], r[3]), pk_bf16(r[4], r[5]), pk_bf16(r[6], r[7])};
        }
      }
      __syncthreads();
    } else {
      const int b = it - 2048; const int c = tid * 4;
      const f32x4 o = *(const f32x4*)(p.osamp + (size_t)b * DM + c);
      float s = o[0] * o[0] + o[1] * o[1] + o[2] * o[2] + o[3] * o[3];
#pragma unroll
      for (int m = 16; m >= 1; m >>= 1) s += __shfl_xor(s, m);
      const float rs = rsqrtf(s * (1.f / 128.f) + 1e-6f);
      const f32x4 ow = *(const f32x4*)(p.dn_o_norm_w + (c & 127));
      const size_t go = (size_t)(MP + b) * DM + c;
      const u32x2 zz = *(const u32x2*)(p.zb + go);
      const float z0 = __uint_as_float(zz[0] << 16), z1 = __uint_as_float(zz[0] & 0xffff0000u), z2 = __uint_as_float(zz[1] << 16), z3 = __uint_as_float(zz[1] & 0xffff0000u);
      *(u32x2*)(p.actA + go) = (u32x2){pk_bf16(o[0] * rs * ow[0] * silu_f(z0), o[1] * rs * ow[1] * silu_f(z1)), pk_bf16(o[2] * rs * ow[2] * silu_f(z2), o[3] * rs * ow[3] * silu_f(z3))};
    }
  }
}

#define XB_XCNT(j) (64 * (j))
#define XB_XSUB(j) (1024 + 64 * (j))
#define XB_XGEN(j) (2048 + 64 * (j))
#define XB_TOP     3072
#define XB_TOPGEN  3136
#define XB_WORDS   3200
#define XB_SPIN_CAP (1u << 24)
__device__ __forceinline__ unsigned xb_ld(unsigned* q) { return __hip_atomic_load(q, __ATOMIC_RELAXED, __HIP_MEMORY_SCOPE_AGENT); }
__device__ __forceinline__ unsigned xb_add(unsigned* q, unsigned v) { return __hip_atomic_fetch_add(q, v, __ATOMIC_RELAXED, __HIP_MEMORY_SCOPE_AGENT); }
__device__ __forceinline__ unsigned xb_xcc_id() { return (unsigned)__builtin_amdgcn_s_getreg((3 << 11) | 20) & 0xFu; }
struct XBar { unsigned* bar; unsigned x; volatile unsigned* st; };
__device__ __forceinline__ void grid_barrier(const XBar& b) {
  asm volatile("s_waitcnt vmcnt(0)" ::: "memory");
  __syncthreads();
  if (threadIdx.x == 0) {
    unsigned* bar = b.bar;
    unsigned nloc = b.st[0], nx = b.st[1];
    if (nloc == 0u) {
      const unsigned G = gridDim.x; unsigned sp = 0;
      for (;;) {
        unsigned sum = 0, cnt = 0, mine = 0;
#pragma unroll
        for (unsigned j = 0; j < 16; ++j) { const unsigned c = xb_ld(&bar[XB_XCNT(j)]); sum += c; cnt += (c > 0u) ? 1u : 0u; mine = (j == b.x) ? c : mine; }
        nloc = mine > 0u ? mine : 1u; nx = cnt > 0u ? cnt : 1u;
        if (sum == G || ++sp > XB_SPIN_CAP) break;
        __builtin_amdgcn_s_sleep(2);
      }
      b.st[0] = nloc; b.st[1] = nx;
    }
    const unsigned old = xb_add(&bar[XB_XSUB(b.x)], 1u);
    const unsigned gen = old / nloc;
    if (old + 1u == (gen + 1u) * nloc) {
      __builtin_amdgcn_fence(__ATOMIC_RELEASE, "agent");
      asm volatile("s_waitcnt vmcnt(0)" ::: "memory");
      const unsigned og = xb_add(&bar[XB_TOP], 1u);
      const unsigned tg = og / nx;
      if (og + 1u == (tg + 1u) * nx) xb_add(&bar[XB_TOPGEN], 1u);
      else { unsigned sp = 0; while (xb_ld(&bar[XB_TOPGEN]) == tg && ++sp < XB_SPIN_CAP) __builtin_amdgcn_s_sleep(2); }
      __builtin_amdgcn_fence(__ATOMIC_ACQUIRE, "agent");
      xb_add(&bar[XB_XGEN(b.x)], 1u);
      asm volatile("s_waitcnt vmcnt(0)" ::: "memory");
    } else {
      unsigned sp = 0; while (xb_ld(&bar[XB_XGEN(b.x)]) == gen && ++sp < XB_SPIN_CAP) __builtin_amdgcn_s_sleep(2);
      __builtin_amdgcn_fence(__ATOMIC_ACQUIRE, "agent");
      asm volatile("s_waitcnt vmcnt(0)" ::: "memory");
    }
  }
  __syncthreads();
}

constexpr int NPHASE = 16;
__global__ void __launch_bounds__(256, 2) mega(Params p) {
  __shared__ __attribute__((aligned(16))) unsigned char lds[LDS_BYTES + 16];
  cg::grid_group grid = cg::this_grid();
  if (p.phase_lo < 0) grid.sync();
  XBar xb; xb.bar = p.bar; xb.x = xb_xcc_id(); xb.st = (volatile unsigned*)(lds + LDS_BYTES);
  if (threadIdx.x == 0) { xb.st[0] = 0u; xb.st[1] = 0u; (void)xb_add(&p.bar[XB_XCNT(xb.x)], 1u); }
  __syncthreads();
#define PHASE(k, call) if (p.phase_lo <= (k) && (k) < p.phase_hi) { call; if ((k) + 1 < p.phase_hi) grid_barrier(xb); }
  PHASE(0, phase0(p, lds))
  PHASE(1, phase1(p))
  PHASE(2, gemm_rows_phase<0>(p, lds, p.actA, DM, p.WpoolT, 256, 1))
  PHASE(3, norm_to_bf16(p, p.norm2_w, 0))
  PHASE(4, ffn_up_phase(p, lds, 0))
  PHASE(5, gemm_rows_phase<1>(p, lds, p.act, DFF, p.WdnT0, DFF, 11))
  PHASE(6, norm_to_bf16(p, p.norm1_w + DM, 11))
  PHASE(7, dn_in_phase(p, lds))
  PHASE(8, dn_pre_phase(p, lds))
  PHASE(9, dn_scan_phase(p, lds))
  PHASE(10, dn_onorm_phase(p, lds))
  PHASE(11, gemm_rows_phase<1>(p, lds, p.actA, DM, p.WoutT, DM, 4))
  PHASE(12, norm_to_bf16(p, p.norm2_w + DM, 4))
  PHASE(13, ffn_up_phase(p, lds, 1))
  PHASE(14, gemm_rows_phase<1>(p, lds, p.act, DFF, p.WdnT1, DFF, 11))
  PHASE(15, final_norm(p, 11))
}

extern "C" void kernel_launch(void* const* d_in, const int* in_sizes, int n_in, void* d_out, int out_size, void* d_ws, size_t ws_size, hipStream_t stream) {
  static int grid_blocks = 0;
  if (!grid_blocks) {
    int dev = 0, cus = 0, per_cu = 0;
    hipGetDevice(&dev);
    hipDeviceGetAttribute(&cus, hipDeviceAttributeMultiprocessorCount, dev);
    hipOccupancyMaxActiveBlocksPerMultiprocessor(&per_cu, mega, 256, 0);
    if (per_cu > 2) per_cu = 2;
    grid_blocks = cus * per_cu;
    if (grid_blocks < 256 || (grid_blocks & 7)) fprintf(stderr, "unexpected grid %d\n", grid_blocks);
  }
  Params p{};
  const float* const* in = (const float* const*)d_in;
  p.xp = in[0]; p.xs = in[1]; p.st_pool = in[2]; p.st_dnc = in[3]; p.st_ssm = in[4]; p.st_ffn = in[5];
  p.norm1_w = in[6]; p.norm2_w = in[7]; p.final_w = in[8]; p.pool_w = in[9]; p.pool_scale = in[10]; p.dn_w_in = in[11]; p.dn_conv_w = in[12];
  p.dn_a_log = in[13]; p.dn_dt_bias = in[14]; p.dn_o_norm_w = in[15]; p.dn_w_out = in[16]; p.ffn_w_up = in[17]; p.ffn_conv_w = in[18]; p.ffn_conv_b = in[19]; p.ffn_w_down = in[20];
  p.out = (float*)d_out;
  unsigned char* ws = (unsigned char*)d_ws; size_t off = 0;
  auto take = [&](size_t bytes) { unsigned char* r = ws + off; off += (bytes + 255) & ~(size_t)255; return r; };
  unsigned char* w0 = take((size_t)4 * 65536 * 2 + (size_t)DFF2 * DM * 2 + (size_t)DM * DFF * 2);
  p.WpoolT = (bf16_t*)w0; p.WupT0 = (bf16_t*)(w0 + (size_t)4 * 65536 * 2); p.WdnT0 = (bf16_t*)(w0 + (size_t)4 * 65536 * 2 + (size_t)DFF2 * DM * 2);
  p.qkb = (bf16_t*)w0;
  p.WupT1 = (bf16_t*)take((size_t)DFF2 * DM * 2); p.WdnT1 = (bf16_t*)take((size_t)DM * DFF * 2);
  p.WinT = (bf16_t*)take((size_t)DNIN_PAD * DM * 2); p.WoutT = (bf16_t*)take((size_t)DM * DM * 2);
  p.bar = (unsigned*)take((size_t)XB_WORDS * 4);
  p.rstd = (float*)take((size_t)MTOT * 4); p.gbuf = (float*)take((size_t)MTOT * 8 * 4); p.betabuf = (float*)take((size_t)MTOT * 8 * 4);
  p.gcbuf = (float*)take((size_t)2048 * 64 * 4); p.osamp = (float*)take((size_t)MS * DM * 4); p.part = (float*)take((size_t)11 * MS * DM * 4);
  p.actA = (bf16_t*)take((size_t)MTOT * DM * 2); p.win = p.actA;
  unsigned char* big = take(0); const size_t big_off = off;
  p.act = (bf16_t*)big;
  const size_t bsz = (size_t)MTOT * DM * 2;
  p.qb = (bf16_t*)big; p.kb = (bf16_t*)(big + bsz); p.vb = (bf16_t*)(big + 2 * bsz); p.zb = (bf16_t*)(big + 3 * bsz); p.uT = (bf16_t*)(big + 4 * bsz);
  const size_t need = big_off + 4 * bsz + (size_t)2048 * 8192 * 2;
  if (need > ws_size || big_off + (size_t)MTOT * DFF * 2 > ws_size) { fprintf(stderr, "workspace too small: need %zu have %zu\n", need, ws_size); return; }
  p.phase_lo = 0; p.phase_hi = NPHASE;
  hipMemsetAsync(p.bar, 0, (size_t)XB_WORDS * 4, stream);
  void* args[] = {&p};
  hipError_t e = hipLaunchCooperativeKernel((void*)mega, dim3(grid_blocks), dim3(256), args, 0, stream);
  if (e != hipSuccess) fprintf(stderr, "cooperative launch failed: %s (grid %d)\n", hipGetErrorString(e), grid_blocks);
}
```

```cpp
#include <hip/hip_runtime.h>
#include <hip/hip_cooperative_groups.h>
#include <cstdio>
#include <cstdint>
namespace cg = cooperative_groups;

typedef unsigned short bf16_t;
typedef short bf16x8 __attribute__((ext_vector_type(8)));
typedef float f32x4 __attribute__((ext_vector_type(4)));
typedef unsigned u32x4 __attribute__((ext_vector_type(4)));
typedef unsigned u32x2 __attribute__((ext_vector_type(2)));

constexpr int DM = 1024, TSEQ = 2048, NBP = 8, MP = 16384, MS = 128, MTOT = 16512;
constexpr int DFF = 2816, DFF2 = 5632, DNIN = 4112, DNIN_PAD = 4224;
constexpr int LDS_BYTES = 69632;
constexpr int TLD = 132;
constexpr size_t O_YP = 0, O_YS = O_YP + (size_t)MP * DM, O_POOLP = O_YS + (size_t)MS * DM, O_POOLS = O_POOLP + (size_t)NBP * 15 * DM,
                 O_DNCP = O_POOLS + (size_t)MS * 15 * DM, O_DNCS = O_DNCP + (size_t)NBP * 3 * 3072, O_DNSP = O_DNCS + (size_t)MS * 3 * 3072,
                 O_DNSS = O_DNSP + (size_t)NBP * 8 * 128 * 128, O_FFNP = O_DNSS + (size_t)MS * 8 * 128 * 128, O_FFNS = O_FFNP + (size_t)2 * NBP * 2 * DFF2;

struct Params {
  const float *xp, *xs, *st_pool, *st_dnc, *st_ssm, *st_ffn;
  const float *norm1_w, *norm2_w, *final_w, *pool_w, *pool_scale, *dn_w_in, *dn_conv_w, *dn_a_log, *dn_dt_bias, *dn_o_norm_w, *dn_w_out,
      *ffn_w_up, *ffn_conv_w, *ffn_conv_b, *ffn_w_down;
  float* out;
  bf16_t *WpoolT, *WupT0, *WupT1, *WdnT0, *WdnT1, *WinT, *WoutT;
  bf16_t *actA, *act, *qb, *kb, *vb, *zb, *uT, *win, *qkb;
  float *rstd, *gbuf, *betabuf, *gcbuf, *osamp, *part;
  unsigned* bar;
  int phase_lo, phase_hi;
};

__device__ __forceinline__ float bf2f(bf16_t b) { return __uint_as_float(((unsigned)b) << 16); }
typedef float f32x2 __attribute__((ext_vector_type(2)));
typedef __bf16 bf16x2_t __attribute__((ext_vector_type(2)));
__device__ __forceinline__ unsigned pk_bf16(float lo, float hi) { const f32x2 v = {lo, hi}; const bf16x2_t b = __builtin_convertvector(v, bf16x2_t); return __builtin_bit_cast(unsigned, b); }
__device__ __forceinline__ bf16_t f2bf(float x) { return (bf16_t)(pk_bf16(x, 0.f) & 0xffffu); }
template <int CTRL> __device__ __forceinline__ float dpp_add(float v) {
  return v + __builtin_bit_cast(float, __builtin_amdgcn_update_dpp(0, __builtin_bit_cast(int, v), CTRL, 0xF, 0xF, true));
}
__device__ __forceinline__ float wave_sum(float v) {
  v = dpp_add<0xB1>(v);
  v = dpp_add<0x4E>(v);
  v = dpp_add<0x141>(v);
  v = dpp_add<0x140>(v);
  const int vi = __builtin_bit_cast(int, v);
  const float r0 = __builtin_bit_cast(float, __builtin_amdgcn_readlane(vi, 0)), r1 = __builtin_bit_cast(float, __builtin_amdgcn_readlane(vi, 16));
  const float r2 = __builtin_bit_cast(float, __builtin_amdgcn_readlane(vi, 32)), r3 = __builtin_bit_cast(float, __builtin_amdgcn_readlane(vi, 48));
  return (r0 + r1) + (r2 + r3);
}
__device__ __forceinline__ float silu_f(float x) { return x * __builtin_amdgcn_rcpf(1.f + __expf(-x)); }
__device__ __forceinline__ f32x4 mfma16(bf16x8 a, bf16x8 b, f32x4 c) { return __builtin_amdgcn_mfma_f32_16x16x32_bf16(a, b, c, 0, 0, 0); }

#define LAS __attribute__((address_space(3)))
__device__ __forceinline__ void gemm_mainloop(unsigned char* lds, const bf16_t* __restrict__ A, int lda, const int (&arow)[4], int acol0,
                                              const bf16_t* __restrict__ Bt, int ldb, int n0, int bcol0, int K, f32x4 (&acc)[4][4]) {
  const int tid = threadIdx.x, lane = tid & 63, w = tid >> 6, wm = w >> 1, wn = w & 1, r16 = lane & 15, quad = lane >> 4;
  const int lrow = tid >> 3;
  const int chl = (tid & 7) ^ ((lrow >> 1) & 7);
  const bf16_t* pa[4]; const bf16_t* pb[4];
#pragma unroll
  for (int i = 0; i < 4; ++i) { pa[i] = A + (size_t)arow[i] * lda + acol0 + chl * 8; pb[i] = Bt + (size_t)(n0 + lrow + 32 * i) * ldb + bcol0 + chl * 8; }
  LAS unsigned char* sA = (LAS unsigned char*)lds; LAS unsigned char* sB = sA + 32768;
  const unsigned wbase = (unsigned)__builtin_amdgcn_readfirstlane(w) * 1024u;
#pragma unroll
  for (int mi = 0; mi < 4; ++mi)
#pragma unroll
    for (int ni = 0; ni < 4; ++ni) acc[mi][ni] = (f32x4){0.f, 0.f, 0.f, 0.f};
#pragma unroll
  for (int i = 0; i < 4; ++i) {
    __builtin_amdgcn_global_load_lds((const unsigned*)pa[i], (LAS unsigned*)(sA + wbase + i * 4096), 16, 0, 0);
    __builtin_amdgcn_global_load_lds((const unsigned*)pb[i], (LAS unsigned*)(sB + wbase + i * 4096), 16, 0, 0);
  }
  __syncthreads();
  const int nk = K >> 6;
  const unsigned a_rd = (wm * 64 + r16) * 128, b_rd = (wn * 64 + r16) * 128; const int sw = r16 >> 1;
  for (int kt = 0; kt < nk; ++kt) {
    const int cur = kt & 1;
    const LAS unsigned char* cA = sA + cur * 16384 + a_rd; const LAS unsigned char* cB = sB + cur * 16384 + b_rd;
    {
      bf16x8 af[2][4], bfr[2][4];
#pragma unroll
      for (int ks = 0; ks < 2; ++ks) {
        const unsigned co = (unsigned)(((ks * 4 + quad) ^ sw) << 4);
#pragma unroll
        for (int mi = 0; mi < 4; ++mi) af[ks][mi] = *(const LAS bf16x8*)(cA + mi * 2048 + co);
#pragma unroll
        for (int ni = 0; ni < 4; ++ni) bfr[ks][ni] = *(const LAS bf16x8*)(cB + ni * 2048 + co);
      }
      if (kt + 1 < nk) {
        const int k0 = (kt + 1) << 6;
#pragma unroll
        for (int i = 0; i < 4; ++i) {
          __builtin_amdgcn_global_load_lds((const unsigned*)(pa[i] + k0), (LAS unsigned*)(sA + (cur ^ 1) * 16384 + wbase + i * 4096), 16, 0, 0);
          __builtin_amdgcn_global_load_lds((const unsigned*)(pb[i] + k0), (LAS unsigned*)(sB + (cur ^ 1) * 16384 + wbase + i * 4096), 16, 0, 0);
        }
      }
      __builtin_amdgcn_s_setprio(1);
#pragma unroll
      for (int ks = 0; ks < 2; ++ks)
#pragma unroll
        for (int mi = 0; mi < 4; ++mi)
#pragma unroll
          for (int ni = 0; ni < 4; ++ni) acc[mi][ni] = mfma16(bfr[ks][ni], af[ks][mi], acc[mi][ni]);
      __builtin_amdgcn_s_setprio(0);
    }
    __syncthreads();
  }
}

__device__ __forceinline__ void acc_to_lds(unsigned char* lds, const f32x4 (&acc)[4][4]) {
  const int tid = threadIdx.x, lane = tid & 63, w = tid >> 6, wm = w >> 1, wn = w & 1, r16 = lane & 15, quad = lane >> 4;
  float* T = (float*)lds;
#pragma unroll
  for (int mi = 0; mi < 4; ++mi)
#pragma unroll
    for (int ni = 0; ni < 4; ++ni) *(f32x4*)(T + (wm * 64 + mi * 16 + r16) * TLD + wn * 64 + ni * 16 + quad * 4) = acc[mi][ni];
}

__device__ __forceinline__ int unit_linear(int u, int G, int total) {
  const int base = (u / G) * G;
  if (base + G > total) return u;
  const int x = u & 7, v = (u % G) >> 3; return base + x * (G >> 3) + v;
}
__device__ __forceinline__ bool unit_decode(int L, int nRT, int nCT, int& rt, int& ct) {
  const int per = 8 * nCT; const int sg = L / per; const int rem = L - sg * per; ct = rem >> 3; rt = sg * 8 + (rem & 7);
  return rt < nRT;
}

__device__ __forceinline__ void transpose_tile(unsigned char* lds, const float* __restrict__ src, int ld_src, int k0, int nsrc0, int nvalid, bf16_t* __restrict__ dst, int ld_dst, int ndst0) {
  float* T = (float*)lds;
  const int tid = threadIdx.x;
  f32x4 v[4];
#pragma unroll
  for (int m = 0; m < 4; ++m) {
    const int q = tid + 256 * m, k = q >> 4, n4 = (q & 15) * 4;
    const float* sp = src + (size_t)(k0 + k) * ld_src + nsrc0 + n4;
    if (n4 + 3 < nvalid) v[m] = *(const f32x4*)sp;
    else { v[m] = (f32x4){0.f, 0.f, 0.f, 0.f};
#pragma unroll
      for (int j = 0; j < 4; ++j) if (n4 + j < nvalid) v[m][j] = sp[j]; }
  }
#pragma unroll
  for (int m = 0; m < 4; ++m) { const int q = tid + 256 * m, k = q >> 4, n4 = (q & 15) * 4; *(f32x4*)(T + k * 68 + n4) = v[m]; }
  __syncthreads();
  const int n = tid >> 2, kseg = (tid & 3) * 16;
  unsigned pk[8];
#pragma unroll
  for (int i = 0; i < 8; ++i) pk[i] = pk_bf16(T[(kseg + 2 * i) * 68 + n], T[(kseg + 2 * i + 1) * 68 + n]);
  bf16_t* d = dst + (size_t)(ndst0 + n) * ld_dst + k0 + kseg;
  *(u32x4*)(d) = (u32x4){pk[0], pk[1], pk[2], pk[3]};
  *(u32x4*)(d + 8) = (u32x4){pk[4], pk[5], pk[6], pk[7]};
  __syncthreads();
}

__device__ __forceinline__ void rstd_rows(const Params& p) {
  const int lane = threadIdx.x & 63; const int gw = (blockIdx.x * 256 + threadIdx.x) >> 6, nw = gridDim.x * 4;
  for (int r = gw; r < MTOT; r += nw) {
    const float* x = (r < MP) ? p.xp + (size_t)r * DM : p.xs + (size_t)(r - MP) * DM;
    float s = 0.f;
#pragma unroll
    for (int m = 0; m < 4; ++m) { const f32x4 v = *(const f32x4*)(x + lane * 4 + 256 * m); s += v[0] * v[0] + v[1] * v[1] + v[2] * v[2] + v[3] * v[3]; }
    s = wave_sum(s);
    if (lane == 0) p.rstd[r] = rsqrtf(s * (1.f / DM) + 1e-6f);
  }
}

__device__ __forceinline__ void phase0(const Params& p, unsigned char* lds) {
  for (int job = blockIdx.x; job < 5600; job += gridDim.x) {
    int j = job;
    if (j < 64) { const int g = j >> 4, t = j & 15, kt = t >> 2, nt = t & 3;
      transpose_tile(lds, p.pool_w + (size_t)g * 65536, 256, kt * 64, nt * 64, 64, p.WpoolT + (size_t)g * 65536, 256, nt * 64); continue; }
    j -= 64;
    if (j < 2816) { const int layer = j / 1408, t = j % 1408, kt = t / 88, nb = t % 88;
      const int ct = nb >> 1, isval = nb & 1; const int nsrc0 = isval ? DFF + ct * 64 : ct * 64;
      transpose_tile(lds, p.ffn_w_up + (size_t)layer * DM * DFF2, DFF2, kt * 64, nsrc0, 64, layer ? p.WupT1 : p.WupT0, DM, nb * 64); continue; }
    j -= 2816;
    if (j < 1408) { const int layer = j / 704, t = j % 704, kt = t / 16, nb = t % 16;
      transpose_tile(lds, p.ffn_w_down + (size_t)layer * DFF * DM, DM, kt * 64, nb * 64, 64, layer ? p.WdnT1 : p.WdnT0, DFF, nb * 64); continue; }
    j -= 1408;
    if (j < 1056) { const int kt = j / 66, nb = j % 66; const int nv = (DNIN - nb * 64) < 0 ? 0 : ((DNIN - nb * 64) > 64 ? 64 : (DNIN - nb * 64));
      transpose_tile(lds, p.dn_w_in, DNIN, kt * 64, nb * 64, nv, p.WinT, DM, nb * 64); continue; }
    j -= 1056;
    { const int kt = j >> 4, nb = j & 15; transpose_tile(lds, p.dn_w_out, DM, kt * 64, nb * 64, 64, p.WoutT, DM, nb * 64); }
  }
  rstd_rows(p);
  const size_t gt = (size_t)blockIdx.x * 256 + threadIdx.x, gn = (size_t)gridDim.x * 256;
  for (size_t i = gt; i < (size_t)MS * 14 * 256; i += gn) {
    const size_t c4 = i & 255, r = (i >> 8) % 14, b = (i >> 8) / 14;
    *(f32x4*)(p.out + O_POOLS + (b * 15 + r) * DM + c4 * 4) = *(const f32x4*)(p.st_pool + (b * 15 + r + 1) * DM + c4 * 4);
  }
  for (size_t i = gt; i < (size_t)MS * 2 * 768; i += gn) {
    const size_t c4 = i % 768, r = (i / 768) & 1, b = i / 1536;
    *(f32x4*)(p.out + O_DNCS + (b * 3 + r) * 3072 + c4 * 4) = *(const f32x4*)(p.st_dnc + (b * 3 + r + 1) * 3072 + c4 * 4);
  }
  for (size_t i = gt; i < (size_t)2 * MS * 1408; i += gn) {
    const size_t c4 = i % 1408, lb = i / 1408;
    *(f32x4*)(p.out + O_FFNS + (lb * 2 + 0) * DFF2 + c4 * 4) = *(const f32x4*)(p.st_ffn + (lb * 2 + 1) * DFF2 + c4 * 4);
  }
}

__device__ __forceinline__ void phase1(const Params& p) {
  const int gt = blockIdx.x * 256 + threadIdx.x, gn = gridDim.x * 256;
  const float* w1 = p.norm1_w;
  for (int idx = gt; idx < 1024 * 256; idx += gn) {
    const int f4 = idx & 255, strip = idx >> 8, b = strip >> 7, t0 = (strip & 127) * 16, c = f4 * 4, g = f4 >> 6, win = 2 << g;
    const f32x4 wv = *(const f32x4*)(w1 + c);
    const float* xb = p.xp + (size_t)b * TSEQ * DM + c; const float* rs = p.rstd + b * TSEQ;
    f32x4 s = (f32x4){0.f, 0.f, 0.f, 0.f};
    for (int j = 1; j < win; ++j) { const int t = t0 - j; if (t >= 0) s += *(const f32x4*)(xb + (size_t)t * DM) * rs[t] * wv; }
    for (int tt = 0; tt < 16; ++tt) {
      const int t = t0 + tt;
      const f32x4 ht = *(const f32x4*)(xb + (size_t)t * DM) * rs[t] * wv;
      s += ht;
      const int cnt = (t + 1 < win) ? (t + 1) : win;
      const f32x4 dgv = s * __builtin_amdgcn_rcpf((float)cnt) - ht;
      *(u32x2*)(p.actA + (size_t)(b * TSEQ + t) * DM + c) = (u32x2){pk_bf16(dgv[0], dgv[1]), pk_bf16(dgv[2], dgv[3])};
      if (t >= TSEQ - 15) *(f32x4*)(p.out + O_POOLP + ((size_t)b * 15 + (t - (TSEQ - 15))) * DM + c) = ht;
      const int to = t - win + 1;
      if (to >= 0) s -= *(const f32x4*)(xb + (size_t)to * DM) * rs[to] * wv;
    }
  }
  for (int idx = gt; idx < MS * 256; idx += gn) {
    const int f4 = idx & 255, b = idx >> 8, c = f4 * 4, g = f4 >> 6, win = 2 << g;
    const f32x4 wv = *(const f32x4*)(w1 + c);
    const f32x4 ht = *(const f32x4*)(p.xs + (size_t)b * DM + c) * p.rstd[MP + b] * wv;
    f32x4 s = ht;
    for (int j = 1; j < win; ++j) s += *(const f32x4*)(p.st_pool + ((size_t)b * 15 + (15 - j)) * DM + c);
    const f32x4 dgv = s * __builtin_amdgcn_rcpf((float)win) - ht;
    *(u32x2*)(p.actA + (size_t)(MP + b) * DM + c) = (u32x2){pk_bf16(dgv[0], dgv[1]), pk_bf16(dgv[2], dgv[3])};
    *(f32x4*)(p.out + O_POOLS + ((size_t)b * 15 + 14) * DM + c) = ht;
  }
}

template <int MODE>
__device__ __forceinline__ void gemm_rows_phase(const Params& p, unsigned char* lds, const bf16_t* A, int lda, const bf16_t* Bt, int K, int ksplit) {
  const int G = gridDim.x, nCT = 8;
  const int nRT = (MODE == 0) ? MTOT / 128 : MP / 128;
  const int nmain = ((nRT + 7) / 8) * 8 * nCT, total = nmain + ((MODE == 0) ? 0 : 8 * ksplit);
  const int tid = threadIdx.x, lane = tid & 63, w = tid >> 6, wm = w >> 1, wn = w & 1, r16 = lane & 15, quad = lane >> 4;
  const int nround = (total + G - 1) / G;
  for (int rd = 0; rd < nround; ++rd) {
    const int L = unit_linear(rd * G + blockIdx.x, G, total);
    int rt, ct, kofs = 0, klen = K; bool sub = false;
    if (L >= total) continue;
    if (L < nmain) { if (!unit_decode(L, nRT, nCT, rt, ct)) continue; }
    else { const int idx = L - nmain; ct = idx & 7; rt = MP / 128; klen = K / ksplit; kofs = (idx >> 3) * klen; sub = true; }
    int arow[4];
#pragma unroll
    for (int i = 0; i < 4; ++i) arow[i] = rt * 128 + (tid >> 3) + 32 * i;
    f32x4 acc[4][4];
    if (MODE == 0) gemm_mainloop(lds, A, lda, arow, (ct >> 1) * 256, Bt + (size_t)(ct >> 1) * 65536, 256, (ct & 1) * 128, 0, 256, acc);
    else gemm_mainloop(lds, A, lda, arow, kofs, Bt, K, ct * 128, kofs, klen, acc);
#pragma unroll
    for (int mi = 0; mi < 4; ++mi) {
      const int row = rt * 128 + wm * 64 + mi * 16 + r16;
      float* orow = p.out + (size_t)row * DM;
#pragma unroll
      for (int ni = 0; ni < 4; ++ni) {
        const int col = ct * 128 + wn * 64 + ni * 16 + quad * 4;
        if (MODE == 0) {
          const float* xin = (row < MP) ? p.xp + (size_t)row * DM : p.xs + (size_t)(row - MP) * DM;
          *(f32x4*)(orow + col) = *(const f32x4*)(xin + col) + acc[mi][ni] * *(const f32x4*)(p.pool_scale + col);
        } else if (!sub) {
          *(f32x4*)(orow + col) = *(const f32x4*)(orow + col) + acc[mi][ni];
        } else {
#pragma unroll
          for (int j = 0; j < 4; ++j) (void)0;
          *(f32x4*)(p.part + ((size_t)(kofs / klen) * MS + (row - MP)) * DM + col) = acc[mi][ni];
        }
      }
    }
  }
}

__device__ __forceinline__ void norm_load_row(const Params& p, int r, int lane, int npart, f32x4 (&v)[4]) {
  const float* x = p.out + (size_t)r * DM;
#pragma unroll
  for (int m = 0; m < 4; ++m) v[m] = *(const f32x4*)(x + lane * 4 + 256 * m);
  if (r >= MP) {
    const float* part = p.part; asm volatile("" : "+v"(part));
    for (int k = 0; k < npart; ++k)
#pragma unroll
      for (int m = 0; m < 4; ++m) v[m] += *(const f32x4*)(part + ((size_t)k * MS + (r - MP)) * DM + lane * 4 + 256 * m);
  }
}
__device__ __forceinline__ void norm_to_bf16(const Params& p, const float* wgt, int npart) {
  const int lane = threadIdx.x & 63; const int gw = (blockIdx.x * 256 + threadIdx.x) >> 6, nw = gridDim.x * 4;
  f32x4 wv[4];
#pragma unroll
  for (int m = 0; m < 4; ++m) wv[m] = *(const f32x4*)(wgt + lane * 4 + 256 * m);
  f32x4 v[4], vn[4];
  if (gw < MTOT) norm_load_row(p, gw, lane, npart, v);
  for (int r = gw; r < MTOT; r += nw) {
    const bool more = r + nw < MTOT;
    if (more) norm_load_row(p, r + nw, lane, npart, vn);
    float s = 0.f;
#pragma unroll
    for (int m = 0; m < 4; ++m) s += v[m][0] * v[m][0] + v[m][1] * v[m][1] + v[m][2] * v[m][2] + v[m][3] * v[m][3];
    s = wave_sum(s);
    const float rs = rsqrtf(s * (1.f / DM) + 1e-6f);
    if (r >= MP && npart > 0) {
#pragma unroll
      for (int m = 0; m < 4; ++m) *(f32x4*)(p.out + (size_t)r * DM + lane * 4 + 256 * m) = v[m];
    }
#pragma unroll
    for (int m = 0; m < 4; ++m) { const f32x4 o = v[m] * rs * wv[m];
      *(u32x2*)(p.actA + (size_t)r * DM + lane * 4 + 256 * m) = (u32x2){pk_bf16(o[0], o[1]), pk_bf16(o[2], o[3])}; }
    if (more) {
#pragma unroll
      for (int m = 0; m < 4; ++m) v[m] = vn[m];
    }
  }
}
__device__ __forceinline__ void final_norm(const Params& p, int npart) {
  const int lane = threadIdx.x & 63; const int gw = (blockIdx.x * 256 + threadIdx.x) >> 6, nw = gridDim.x * 4;
  f32x4 wv[4];
#pragma unroll
  for (int m = 0; m < 4; ++m) wv[m] = *(const f32x4*)(p.final_w + lane * 4 + 256 * m);
  f32x4 v[4], vn[4];
  if (gw < MTOT) norm_load_row(p, gw, lane, npart, v);
  for (int r = gw; r < MTOT; r += nw) {
    const bool more = r + nw < MTOT;
    if (more) norm_load_row(p, r + nw, lane, npart, vn);
    float s = 0.f;
#pragma unroll
    for (int m = 0; m < 4; ++m) s += v[m][0] * v[m][0] + v[m][1] * v[m][1] + v[m][2] * v[m][2] + v[m][3] * v[m][3];
    s = wave_sum(s);
    const float rs = rsqrtf(s * (1.f / DM) + 1e-6f);
#pragma unroll
    for (int m = 0; m < 4; ++m) *(f32x4*)(p.out + (size_t)r * DM + lane * 4 + 256 * m) = v[m] * rs * wv[m];
    if (more) {
#pragma unroll
      for (int m = 0; m < 4; ++m) v[m] = vn[m];
    }
  }
}

__device__ __forceinline__ void ffn_up_phase(const Params& p, unsigned char* lds, int layer) {
  const int G = gridDim.x, nRT = NBP * 17 + 1, nCT = 44, total = ((nRT + 7) / 8) * 8 * nCT;
  const int tid = threadIdx.x;
  const bf16_t* Bt = layer ? p.WupT1 : p.WupT0;
  const float* cw = p.ffn_conv_w + (size_t)layer * 3 * DFF2; const float* cb = p.ffn_conv_b + (size_t)layer * DFF2;
  const int nround = (total + G - 1) / G;
  for (int rd = 0; rd < nround; ++rd) {
    const int L = unit_linear(rd * G + blockIdx.x, G, total);
    int rt, ct;
    if (L >= total || !unit_decode(L, nRT, nCT, rt, ct)) continue;
    const bool samp = (rt == NBP * 17);
    const int b = rt / 17, ti = rt % 17, tbase = 126 * ti - 2;
    int arow[4];
#pragma unroll
    for (int i = 0; i < 4; ++i) { const int l = (tid >> 3) + 32 * i; int t = tbase + l; t = t < 0 ? 0 : (t > TSEQ - 1 ? TSEQ - 1 : t); arow[i] = samp ? MP + l : b * TSEQ + t; }
    f32x4 acc[4][4];
    gemm_mainloop(lds, p.actA, DM, arow, 0, Bt, DM, ct * 128, 0, DM, acc);
    acc_to_lds(lds, acc);
    __syncthreads();
    const float* T = (const float*)lds;
    const int cc = tid & 63, strip = tid >> 6, l0 = strip * 32;
    const int gcol = ct * 64 + cc, vcol = DFF + ct * 64 + cc;
    const float wg0 = cw[gcol], wg1 = cw[DFF2 + gcol], wg2 = cw[2 * DFF2 + gcol], bg = cb[gcol];
    const float wv0 = cw[vcol], wv1 = cw[DFF2 + vcol], wv2 = cw[2 * DFF2 + vcol], bv = cb[vcol];
    if (!samp) {
      const int c2 = (tid & 31) * 2, l0b = (tid >> 5) * 16, ls = l0b < 2 ? 2 : l0b;
      const int gc2 = ct * 64 + c2, vc2 = DFF + ct * 64 + c2;
      typedef float f32x2v __attribute__((ext_vector_type(2)));
      const f32x2v Wg0 = *(const f32x2v*)(cw + gc2), Wg1 = *(const f32x2v*)(cw + DFF2 + gc2), Wg2 = *(const f32x2v*)(cw + 2 * DFF2 + gc2), Bg = *(const f32x2v*)(cb + gc2);
      const f32x2v Wv0 = *(const f32x2v*)(cw + vc2), Wv1 = *(const f32x2v*)(cw + DFF2 + vc2), Wv2 = *(const f32x2v*)(cw + 2 * DFF2 + vc2), Bv = *(const f32x2v*)(cb + vc2);
      f32x2v G2 = *(const f32x2v*)(T + (ls - 2) * TLD + c2), G1 = *(const f32x2v*)(T + (ls - 1) * TLD + c2);
      f32x2v V2 = *(const f32x2v*)(T + (ls - 2) * TLD + 64 + c2), V1 = *(const f32x2v*)(T + (ls - 1) * TLD + 64 + c2);
      if (tbase + ls - 2 < 0) { G2 = (f32x2v){0.f, 0.f}; V2 = G2; }
      if (tbase + ls - 1 < 0) { G1 = (f32x2v){0.f, 0.f}; V1 = G1; }
      for (int l = ls; l < l0b + 16; ++l) {
        const int t = tbase + l; if (t >= TSEQ) break;
        const f32x2v G0 = *(const f32x2v*)(T + l * TLD + c2), V0 = *(const f32x2v*)(T + l * TLD + 64 + c2);
        const f32x2v cg = G2 * Wg0 + G1 * Wg1 + G0 * Wg2 + Bg, cv = V2 * Wv0 + V1 * Wv1 + V0 * Wv2 + Bv;
        *(unsigned*)(p.act + (size_t)(b * TSEQ + t) * DFF + ct * 64 + c2) = pk_bf16(silu_f(cg[0]) * cv[0], silu_f(cg[1]) * cv[1]);
        if (t >= TSEQ - 2) { float* o = p.out + O_FFNP + ((size_t)(layer * NBP + b) * 2 + (t - (TSEQ - 2))) * DFF2; *(f32x2v*)(o + gc2) = G0; *(f32x2v*)(o + vc2) = V0; }
        G2 = G1; G1 = G0; V2 = V1; V1 = V0;
      }
    } else {
      for (int l = l0; l < l0 + 32; ++l) {
        const float g0 = T[l * TLD + cc], v0 = T[l * TLD + 64 + cc];
        const float* st = p.st_ffn + (size_t)(layer * MS + l) * 2 * DFF2;
        const float cgt = st[gcol] * wg0 + st[DFF2 + gcol] * wg1 + g0 * wg2 + bg, cvl = st[vcol] * wv0 + st[DFF2 + vcol] * wv1 + v0 * wv2 + bv;
        p.act[(size_t)(MP + l) * DFF + ct * 64 + cc] = f2bf(silu_f(cgt) * cvl);
        float* o = p.out + O_FFNS + ((size_t)(layer * MS + l) * 2 + 1) * DFF2; o[gcol] = g0; o[vcol] = v0;
      }
    }
    __syncthreads();
  }
}

__device__ __forceinline__ void dn_in_phase(const Params& p, unsigned char* lds) {
  const int G = gridDim.x, nRT = NBP * 17 + 1, nCT = 33, total = ((nRT + 7) / 8) * 8 * nCT;
  const int tid = threadIdx.x, lane = tid & 63, w = tid >> 6;
  const int nround = (total + G - 1) / G;
  for (int rd = 0; rd < nround; ++rd) {
    const int L = unit_linear(rd * G + blockIdx.x, G, total);
    int rt, ct;
    if (L >= total || !unit_decode(L, nRT, nCT, rt, ct)) continue;
    const bool samp = (rt == NBP * 17);
    const int b = rt / 17, ti = rt % 17, tbase = 125 * ti - 3;
    int arow[4];
#pragma unroll
    for (int i = 0; i < 4; ++i) { const int l = (tid >> 3) + 32 * i; int t = tbase + l; t = t < 0 ? 0 : (t > TSEQ - 1 ? TSEQ - 1 : t); arow[i] = samp ? MP + l : b * TSEQ + t; }
    f32x4 acc[4][4];
    gemm_mainloop(lds, p.actA, DM, arow, 0, p.WinT, DM, ct * 128, 0, DM, acc);
    acc_to_lds(lds, acc);
    __syncthreads();
    const float* T = (const float*)lds;
    const int l0 = w * 32;
    if (ct < 24) {
      const int c0 = lane * 2, c1 = lane * 2 + 1, col0 = ct * 128 + c0, col1 = ct * 128 + c1;
      const float* cw = p.dn_conv_w;
      const float a0 = cw[col0], a1 = cw[3072 + col0], a2 = cw[2 * 3072 + col0], a3 = cw[3 * 3072 + col0];
      const float e0 = cw[col1], e1 = cw[3072 + col1], e2 = cw[2 * 3072 + col1], e3 = cw[3 * 3072 + col1];
      bf16_t* dst = (ct < 8) ? p.qb : (ct < 16 ? p.kb : p.vb);
      const int hc = (ct & 7) * 128;
      const float post = (ct < 8) ? 0.08838834764831845f : 1.f;
      if (!samp) {
        const int ls = l0 < 3 ? 3 : l0;
        float x3 = T[(ls - 3) * TLD + c0], x2 = T[(ls - 2) * TLD + c0], x1 = T[(ls - 1) * TLD + c0];
        float y3 = T[(ls - 3) * TLD + c1], y2 = T[(ls - 2) * TLD + c1], y1 = T[(ls - 1) * TLD + c1];
        if (tbase + ls - 3 < 0) { x3 = 0.f; y3 = 0.f; }
        if (tbase + ls - 2 < 0) { x2 = 0.f; y2 = 0.f; }
        if (tbase + ls - 1 < 0) { x1 = 0.f; y1 = 0.f; }
        for (int l = ls; l < l0 + 32; ++l) {
          const int t = tbase + l; if (t >= TSEQ) break;
          const float x0 = T[l * TLD + c0], y0 = T[l * TLD + c1];
          float s0 = silu_f(x3 * a0 + x2 * a1 + x1 * a2 + x0 * a3), s1 = silu_f(y3 * e0 + y2 * e1 + y1 * e2 + y0 * e3);
          if (ct < 16) { const float ss = wave_sum(s0 * s0 + s1 * s1); const float sc = rsqrtf(ss + 1e-6f) * post; s0 *= sc; s1 *= sc; }
          bf16_t* d = dst + (size_t)(b * TSEQ + t) * DM + hc;
          *(unsigned*)(d + c0) = pk_bf16(s0, s1);
          if (t >= TSEQ - 3) { float* o = p.out + O_DNCP + ((size_t)b * 3 + (t - (TSEQ - 3))) * 3072; *(f32x2*)(o + col0) = (f32x2){x0, y0}; }
          x3 = x2; x2 = x1; x1 = x0; y3 = y2; y2 = y1; y1 = y0;
        }
      } else {
        for (int l = l0; l < l0 + 32; ++l) {
          const float x0 = T[l * TLD + c0], y0 = T[l * TLD + c1];
          const float* st = p.st_dnc + (size_t)l * 3 * 3072;
          float s0 = silu_f(st[col0] * a0 + st[3072 + col0] * a1 + st[2 * 3072 + col0] * a2 + x0 * a3);
          float s1 = silu_f(st[col1] * e0 + st[3072 + col1] * e1 + st[2 * 3072 + col1] * e2 + y0 * e3);
          if (ct < 16) { const float ss = wave_sum(s0 * s0 + s1 * s1); const float sc = rsqrtf(ss + 1e-6f) * post; s0 *= sc; s1 *= sc; }
          bf16_t* d = dst + (size_t)(MP + l) * DM + hc;
          *(unsigned*)(d + c0) = pk_bf16(s0, s1);
          float* o = p.out + O_DNCS + ((size_t)l * 3 + 2) * 3072; *(f32x2*)(o + col0) = (f32x2){x0, y0};
        }
      }
    } else if (ct < 32) {
      const int hc = (ct - 24) * 128;
      for (int l = l0; l < l0 + 32; ++l) {
        int row;
        if (samp) row = MP + l; else { const int t = tbase + l; if (l < 3 || t >= TSEQ) continue; row = b * TSEQ + t; }
        bf16_t* d = p.zb + (size_t)row * DM + hc;
        *(unsigned*)(d + 2 * lane) = pk_bf16(T[l * TLD + 2 * lane], T[l * TLD + 2 * lane + 1]);
      }
    } else {
      const int l = tid & 127, part = tid >> 7;
      int row = -1;
      if (samp) row = MP + l; else { const int t = tbase + l; if (l >= 3 && t < TSEQ) row = b * TSEQ + t; }
      if (row >= 0) {
#pragma unroll
        for (int hh = 0; hh < 8; ++hh) {
          if (part == 0) { const float a = T[l * TLD + hh] + p.dn_dt_bias[hh]; const float sp = (a > 0.f ? a : 0.f) + log1pf(__expf(-fabsf(a)));
            p.gbuf[(size_t)row * 8 + hh] = -__expf(p.dn_a_log[hh]) * sp; }
          else { const float bb = T[l * TLD + 8 + hh]; p.betabuf[(size_t)row * 8 + hh] = __builtin_amdgcn_rcpf(1.f + __expf(-bb)); }
        }
      }
    }
    __syncthreads();
  }
}

__device__ __forceinline__ unsigned img256(int row, int c) { return (unsigned)(row * 256 + ((((c >> 3) ^ (row & 15))) << 4) + (c & 7) * 2); }
__device__ __forceinline__ unsigned img128(int row, int c) { return (unsigned)(row * 128 + ((((c >> 3) ^ ((row >> 1) & 7))) << 4) + (c & 7) * 2); }

__device__ __forceinline__ void dn_chunk_item(const Params& p, unsigned char* lds, int item) {
  const int tid = threadIdx.x, lane = tid & 63, w = tid >> 6, r16 = lane & 15, quad = lane >> 4;
  const int h = item & 7, n = (item >> 3) & 31, b = item >> 8;
  const int r0 = b * TSEQ + n * 64;
  unsigned char* kimg = lds; unsigned char* qimg = lds + 16384; unsigned char* vimg = lds + 32768;
  unsigned char* Lbf = lds + 49152;
  float* Ld = (float*)(lds + 49152 + 8192);
  float* gcs = (float*)(lds + 49152 + 17408);
  float* egs = gcs + 64; float* bts = egs + 64;
  if (tid < 64) {
    float val = p.gbuf[(size_t)(r0 + tid) * 8 + h];
#pragma unroll
    for (int off = 1; off < 64; off <<= 1) { const float t = __shfl_up(val, off); if (lane >= off) val += t; }
    gcs[tid] = val; egs[tid] = __expf(val); bts[tid] = p.betabuf[(size_t)(r0 + tid) * 8 + h];
    p.gcbuf[(size_t)item * 64 + tid] = val;
  }
  {
    const int ch = tid & 15;
#pragma unroll
    for (int i = 0; i < 4; ++i) {
      const int row = (tid >> 4) + 16 * i; const size_t go = (size_t)(r0 + row) * DM + h * 128 + ch * 8; const unsigned lo = row * 256 + ((ch ^ (row & 15)) << 4);
      *(u32x4*)(kimg + lo) = *(const u32x4*)(p.kb + go); *(u32x4*)(qimg + lo) = *(const u32x4*)(p.qb + go); *(u32x4*)(vimg + lo) = *(const u32x4*)(p.vb + go);
    }
  }
  __syncthreads();
  {
#pragma unroll
    for (int nt = 0; nt < 4; ++nt) {
      f32x4 ck = (f32x4){0.f, 0.f, 0.f, 0.f}, cq = ck;
      if (nt <= w) {
#pragma unroll
        for (int ks = 0; ks < 4; ++ks) {
          const unsigned o = (16 * w + r16) * 256 + (((ks * 4 + quad) ^ r16) << 4);
          const bf16x8 ak = *(const bf16x8*)(kimg + o), aq = *(const bf16x8*)(qimg + o);
          const bf16x8 bk = *(const bf16x8*)(kimg + (16 * nt + r16) * 256 + (((ks * 4 + quad) ^ r16) << 4)); ck = mfma16(ak, bk, ck); cq = mfma16(aq, bk, cq); }
      }
      const int jc = 16 * nt + r16; const float gj = gcs[jc];
#pragma unroll
      for (int jj = 0; jj < 4; ++jj) {
        const int i = 16 * w + quad * 4 + jj;
        const float dec = (jc <= i) ? __expf(gcs[i] - gj) : 0.f;
        const float Lv = (jc < i) ? bts[i] * ck[jj] * dec : 0.f;
        if (nt == w) Ld[(w * 16 + quad * 4 + jj) * 16 + r16] = Lv;
        *(bf16_t*)(Lbf + img128(i, jc)) = (nt < w) ? f2bf(Lv) : (bf16_t)0;
        p.qkb[(size_t)item * 4096 + i * 64 + jc] = f2bf(cq[jj] * dec);
      }
    }
  }
  __syncthreads();
  {
    const int ch = tid & 15;
#pragma unroll
    for (int i = 0; i < 4; ++i) {
      const int row = (tid >> 4) + 16 * i; const float e = egs[row];
      const u32x4 qv = *(const u32x4*)(qimg + row * 256 + ((ch ^ (row & 15)) << 4));
      u32x4 o;
#pragma unroll
      for (int j = 0; j < 4; ++j) o[j] = pk_bf16(__uint_as_float(qv[j] << 16) * e, __uint_as_float(qv[j] & 0xffff0000u) * e);
      *(u32x4*)(p.qb + (size_t)(r0 + row) * DM + h * 128 + ch * 8) = o;
    }
    const int i = tid & 63; const float e = __expf(gcs[63] - gcs[i]);
#pragma unroll 4
    for (int m = 0; m < 32; ++m) {
      const int d = (tid >> 6) + 4 * m;
      const float kv = bf2f(*(const bf16_t*)(kimg + img256(i, d)));
      p.vb[(size_t)(r0 + (d >> 1)) * DM + h * 128 + (d & 1) * 64 + i] = f2bf(kv * e);
    }
  }
  {
    const int c = tid; const bool isv = c < 128; const int cl = c & 127;
    unsigned char* XT = lds + 16384;
    float* RT = (float*)lds;
    const int sw_ = (c >> 1) & 7;
    __syncthreads();
    if (isv) {
#pragma unroll
      for (int j8 = 0; j8 < 8; ++j8) {
        float t[8];
#pragma unroll
        for (int j = 0; j < 8; ++j) { const int i = j8 * 8 + j; t[j] = bts[i] * bf2f(*(const bf16_t*)(vimg + img256(i, cl))); }
        *(u32x4*)(XT + c * 128 + ((j8 ^ sw_) << 4)) = (u32x4){pk_bf16(t[0], t[1]), pk_bf16(t[2], t[3]), pk_bf16(t[4], t[5]), pk_bf16(t[6], t[7])};
      }
    }
    __syncthreads();
    if (!isv) {
#pragma unroll
      for (int j8 = 0; j8 < 8; ++j8) {
        float t[8];
#pragma unroll
        for (int j = 0; j < 8; ++j) { const int i = j8 * 8 + j; t[j] = bts[i] * egs[i] * bf2f(*(const bf16_t*)(kimg + img256(i, cl))); }
        *(u32x4*)(XT + c * 128 + ((j8 ^ sw_) << 4)) = (u32x4){pk_bf16(t[0], t[1]), pk_bf16(t[2], t[3]), pk_bf16(t[4], t[5]), pk_bf16(t[6], t[7])};
      }
    }
    __syncthreads();
#pragma unroll 1
    for (int r = 0; r < 4; ++r) {
      float xb[16];
      { const u32x4 lo = *(const u32x4*)(XT + c * 128 + (((2 * r) ^ sw_) << 4)), hi = *(const u32x4*)(XT + c * 128 + (((2 * r + 1) ^ sw_) << 4));
#pragma unroll
        for (int j = 0; j < 4; ++j) { xb[2 * j] = __uint_as_float(lo[j] << 16); xb[2 * j + 1] = __uint_as_float(lo[j] & 0xffff0000u); xb[8 + 2 * j] = __uint_as_float(hi[j] << 16); xb[8 + 2 * j + 1] = __uint_as_float(hi[j] & 0xffff0000u); } }
      if (r > 0) {
#pragma unroll
        for (int nt = 0; nt < 4; ++nt) {
          f32x4 accu = (f32x4){0.f, 0.f, 0.f, 0.f};
          const int ar = 16 * r + r16, br = 64 * w + 16 * nt + r16;
#pragma unroll
          for (int ks = 0; ks < 2; ++ks) {
            const bf16x8 av = *(const bf16x8*)(Lbf + ar * 128 + (((ks * 4 + quad) ^ ((ar >> 1) & 7)) << 4));
            const bf16x8 bv = *(const bf16x8*)(XT + br * 128 + (((ks * 4 + quad) ^ ((br >> 1) & 7)) << 4));
            accu = mfma16(av, bv, accu);
          }
          *(f32x4*)(RT + br * 16 + quad * 4) = accu;
        }
#pragma unroll
        for (int q4 = 0; q4 < 4; ++q4) { const f32x4 t = *(const f32x4*)(RT + c * 16 + q4 * 4); xb[q4 * 4] -= t[0]; xb[q4 * 4 + 1] -= t[1]; xb[q4 * 4 + 2] -= t[2]; xb[q4 * 4 + 3] -= t[3]; }
      }
#pragma unroll
      for (int i = 1; i < 16; ++i) {
        const float lrow = Ld[(r * 16 + i) * 16 + (lane & 15)];
        float a = xb[i];
#pragma unroll
        for (int j = 0; j < i; ++j) a -= __builtin_bit_cast(float, __builtin_amdgcn_readlane(__builtin_bit_cast(int, lrow), j)) * xb[j];
        xb[i] = a;
      }
      *(u32x4*)(XT + c * 128 + (((2 * r) ^ sw_) << 4)) = (u32x4){pk_bf16(xb[0], xb[1]), pk_bf16(xb[2], xb[3]), pk_bf16(xb[4], xb[5]), pk_bf16(xb[6], xb[7])};
      *(u32x4*)(XT + c * 128 + (((2 * r + 1) ^ sw_) << 4)) = (u32x4){pk_bf16(xb[8], xb[9]), pk_bf16(xb[10], xb[11]), pk_bf16(xb[12], xb[13]), pk_bf16(xb[14], xb[15])};
    }
    int item_o = item; asm volatile("" : "+s"(item_o));
    if (isv) {
      bf16_t* d = p.uT + ((size_t)item_o * 128 + cl) * 64;
#pragma unroll
      for (int j8 = 0; j8 < 8; ++j8) *(u32x4*)(d + j8 * 8) = *(const u32x4*)(XT + c * 128 + ((j8 ^ sw_) << 4));
    } else {
      bf16_t* d = p.win + (size_t)item_o * 8192 + cl;
#pragma unroll
      for (int j8 = 0; j8 < 8; ++j8) {
        const u32x4 v8 = *(const u32x4*)(XT + c * 128 + ((j8 ^ sw_) << 4));
#pragma unroll
        for (int j = 0; j < 4; ++j) { d[(j8 * 8 + 2 * j) * 128] = (bf16_t)(v8[j] & 0xffffu); d[(j8 * 8 + 2 * j + 1) * 128] = (bf16_t)(v8[j] >> 16); }
      }
    }
  }
  __syncthreads();
}

__device__ __forceinline__ void dn_sample_item(const Params& p, unsigned char* lds, int item) {
  const int tid = threadIdx.x, h = item & 7, b = item >> 3, v4 = (tid & 31) * 4, kq = tid >> 5, k0 = kq * 16;
  float* qf = (float*)lds; float* kf = qf + 128; float* red = kf + 128;
  const size_t row = (size_t)(MP + b);
  if (tid < 128) qf[tid] = bf2f(p.qb[row * DM + h * 128 + tid]); else kf[tid - 128] = bf2f(p.kb[row * DM + h * 128 + tid - 128]);
  const float eg = __expf(p.gbuf[row * 8 + h]), beta = p.betabuf[row * 8 + h];
  const u32x2 vraw = *(const u32x2*)(p.vb + row * DM + h * 128 + v4);
  const f32x4 vv = (f32x4){__uint_as_float(vraw[0] << 16), __uint_as_float(vraw[0] & 0xffff0000u), __uint_as_float(vraw[1] << 16), __uint_as_float(vraw[1] & 0xffff0000u)};
  const float* S = p.st_ssm + ((size_t)(b * 8 + h) * 128 + k0) * 128 + v4;
  f32x4 s[16];
#pragma unroll
  for (int k = 0; k < 16; ++k) s[k] = *(const f32x4*)(S + (size_t)k * 128);
  __syncthreads();
  f32x4 ks = (f32x4){0.f, 0.f, 0.f, 0.f}, qs = ks; float qk = 0.f;
#pragma unroll
  for (int k = 0; k < 16; ++k) { ks += s[k] * kf[k0 + k]; qs += s[k] * qf[k0 + k]; }
#pragma unroll 8
  for (int k = 0; k < 128; ++k) qk += qf[k] * kf[k];
  *(f32x4*)(red + kq * 256 + v4) = ks; *(f32x4*)(red + kq * 256 + 128 + v4) = qs;
  __syncthreads();
  f32x4 kst = (f32x4){0.f, 0.f, 0.f, 0.f}, qst = kst;
#pragma unroll
  for (int g = 0; g < 8; ++g) { kst += *(const f32x4*)(red + g * 256 + v4); qst += *(const f32x4*)(red + g * 256 + 128 + v4); }
  const f32x4 u = (vv - kst * eg) * beta;
  if (kq == 0) *(f32x4*)(p.osamp + (size_t)b * DM + h * 128 + v4) = qst * eg + u * qk;
  float* So = p.out + O_DNSS + ((size_t)(b * 8 + h) * 128 + k0) * 128 + v4;
#pragma unroll
  for (int k = 0; k < 16; ++k) *(f32x4*)(So + (size_t)k * 128) = s[k] * eg + u * kf[k0 + k];
  __syncthreads();
}

__device__ __forceinline__ void dn_pre_phase(const Params& p, unsigned char* lds) {
  for (int it = blockIdx.x; it < 2048; it += gridDim.x) dn_chunk_item(p, lds, it);
  for (int it = blockIdx.x; it < 1024; it += gridDim.x) dn_sample_item(p, lds, it);
}

__device__ __forceinline__ void dn_scan_phase(const Params& p, unsigned char* lds) {
  if (blockIdx.x >= 256) return;
  const int tid = threadIdx.x, lane = tid & 63, w = tid >> 6, r16 = lane & 15, quad = lane >> 4;
  const int xcd = blockIdx.x & 7, slot = blockIdx.x >> 3; const int pair = xcd * 8 + (slot >> 2), vs = slot & 3;
  const int b = pair >> 3, h = pair & 7;
  unsigned char* Wimg = lds; unsigned char* Qimg = lds + 16384; unsigned char* KTimg = lds + 32768; unsigned char* QKimg = lds + 49152;
  unsigned char* STimg = lds + 57344; unsigned char* UTimg = lds + 65536;
  for (int i = tid; i < 8192 / 16; i += 256) *(u32x4*)(STimg + i * 16) = (u32x4){0u, 0u, 0u, 0u};
  f32x4 accS[2][2];
#pragma unroll
  for (int a = 0; a < 2; ++a)
#pragma unroll
    for (int c = 0; c < 2; ++c) accS[a][c] = (f32x4){0.f, 0.f, 0.f, 0.f};
  u32x4 rw[4], rq[4], rk[4], rqk[2]; u32x2 ruc[2]; float gl_next;
  auto prefetch = [&](int n) {
    const int item = (b * 32 + n) * 8 + h; const int r0 = b * TSEQ + n * 64;
#pragma unroll
    for (int i = 0; i < 4; ++i) {
      const int q = tid + 256 * i;
      { const int row = q >> 4, ch = q & 15; rw[i] = *(const u32x4*)(p.win + (size_t)item * 8192 + row * 128 + ch * 8); rq[i] = *(const u32x4*)(p.qb + (size_t)(r0 + row) * DM + h * 128 + ch * 8); }
      { const int kidx = q >> 3, ch = q & 7; rk[i] = *(const u32x4*)(p.vb + (size_t)(r0 + (kidx >> 1)) * DM + h * 128 + (kidx & 1) * 64 + ch * 8); }
    }
#pragma unroll
    for (int i = 0; i < 2; ++i) { const int q = tid + 256 * i; const int row = q >> 3, ch = q & 7; rqk[i] = *(const u32x4*)(p.qkb + (size_t)item * 4096 + row * 64 + ch * 8); }
#pragma unroll
    for (int nt = 0; nt < 2; ++nt) ruc[nt] = *(const u32x2*)(p.uT + ((size_t)item * 128 + vs * 32 + nt * 16 + r16) * 64 + 16 * w + quad * 4);
    gl_next = p.gcbuf[(size_t)item * 64 + 63];
  };
  prefetch(0);
  for (int n = 0; n < 32; ++n) {
    const int item = (b * 32 + n) * 8 + h;
#pragma unroll
    for (int i = 0; i < 4; ++i) {
      const int q = tid + 256 * i;
      { const int row = q >> 4, ch = q & 15; const unsigned lo = row * 256 + ((ch ^ (row & 15)) << 4); *(u32x4*)(Wimg + lo) = rw[i]; *(u32x4*)(Qimg + lo) = rq[i]; }
      { const int kidx = q >> 3, ch = q & 7; *(u32x4*)(KTimg + kidx * 128 + ((ch ^ ((kidx >> 1) & 7)) << 4)) = rk[i]; }
    }
#pragma unroll
    for (int i = 0; i < 2; ++i) { const int q = tid + 256 * i; const int row = q >> 3, ch = q & 7; *(u32x4*)(QKimg + row * 128 + ((ch ^ ((row >> 1) & 7)) << 4)) = rqk[i]; }
    u32x2 uc[2] = {ruc[0], ruc[1]};
    const float egl = __expf(gl_next);
    __syncthreads();
    if (n + 1 < 32) prefetch(n + 1);
    f32x4 aWS[2], aQS[2];
#pragma unroll
    for (int nt = 0; nt < 2; ++nt) { aWS[nt] = (f32x4){0.f, 0.f, 0.f, 0.f}; aQS[nt] = aWS[nt]; }
#pragma unroll
    for (int ks = 0; ks < 4; ++ks) {
      const unsigned ao = (16 * w + r16) * 256 + (((ks * 4 + quad) ^ r16) << 4);
      const bf16x8 aw = *(const bf16x8*)(Wimg + ao), aq = *(const bf16x8*)(Qimg + ao);
#pragma unroll
      for (int nt = 0; nt < 2; ++nt) {
        const bf16x8 bs = *(const bf16x8*)(STimg + (nt * 16 + r16) * 256 + (((ks * 4 + quad) ^ r16) << 4));
        aWS[nt] = mfma16(aw, bs, aWS[nt]); aQS[nt] = mfma16(aq, bs, aQS[nt]);
      }
    }
#pragma unroll
    for (int nt = 0; nt < 2; ++nt) {
      const float u0 = __uint_as_float(uc[nt][0] << 16) - aWS[nt][0], u1 = __uint_as_float(uc[nt][0] & 0xffff0000u) - aWS[nt][1];
      const float u2 = __uint_as_float(uc[nt][1] << 16) - aWS[nt][2], u3 = __uint_as_float(uc[nt][1] & 0xffff0000u) - aWS[nt][3];
      const int v = nt * 16 + r16; const int chunk = 2 * w + (quad >> 1);
      *(u32x2*)(UTimg + v * 128 + ((chunk ^ ((v >> 1) & 7)) << 4) + (quad & 1) * 8) = (u32x2){pk_bf16(u0, u1), pk_bf16(u2, u3)};
    }
    __syncthreads();
    bf16x8 bu[2][2];
#pragma unroll
    for (int nt = 0; nt < 2; ++nt)
#pragma unroll
      for (int ks = 0; ks < 2; ++ks) { const int v = nt * 16 + r16; bu[nt][ks] = *(const bf16x8*)(UTimg + v * 128 + (((ks * 4 + quad) ^ ((v >> 1) & 7)) << 4)); }
#pragma unroll
    for (int ks = 0; ks < 2; ++ks) {
      const int row = 16 * w + r16;
      const bf16x8 aqk = *(const bf16x8*)(QKimg + row * 128 + (((ks * 4 + quad) ^ ((row >> 1) & 7)) << 4));
#pragma unroll
      for (int nt = 0; nt < 2; ++nt) aQS[nt] = mfma16(aqk, bu[nt][ks], aQS[nt]);
    }
#pragma unroll
    for (int nt = 0; nt < 2; ++nt)
      *(u32x2*)(p.uT + ((size_t)item * 128 + vs * 32 + nt * 16 + r16) * 64 + 16 * w + quad * 4) = (u32x2){pk_bf16(aQS[nt][0], aQS[nt][1]), pk_bf16(aQS[nt][2], aQS[nt][3])};
#pragma unroll
    for (int mt2 = 0; mt2 < 2; ++mt2) {
      const int mt = 2 * w + mt2; const int kidx = mt * 16 + r16;
#pragma unroll
      for (int nt = 0; nt < 2; ++nt) accS[mt2][nt] = accS[mt2][nt] * egl;
#pragma unroll
      for (int ks = 0; ks < 2; ++ks) {
        const bf16x8 akd = *(const bf16x8*)(KTimg + kidx * 128 + (((ks * 4 + quad) ^ ((kidx >> 1) & 7)) << 4));
#pragma unroll
        for (int nt = 0; nt < 2; ++nt) accS[mt2][nt] = mfma16(akd, bu[nt][ks], accS[mt2][nt]);
      }
#pragma unroll
      for (int nt = 0; nt < 2; ++nt) {
        const int v = nt * 16 + r16; const int chunk = 2 * mt + (quad >> 1);
        *(u32x2*)(STimg + v * 256 + ((chunk ^ (v & 15)) << 4) + (quad & 1) * 8) = (u32x2){pk_bf16(accS[mt2][nt][0], accS[mt2][nt][1]), pk_bf16(accS[mt2][nt][2], accS[mt2][nt][3])};
      }
    }
    __syncthreads();
  }
#pragma unroll
  for (int mt2 = 0; mt2 < 2; ++mt2)
#pragma unroll
    for (int nt = 0; nt < 2; ++nt)
#pragma unroll
      for (int jj = 0; jj < 4; ++jj) {
        const int kidx = (2 * w + mt2) * 16 + quad * 4 + jj, v = vs * 32 + nt * 16 + r16;
        p.out[O_DNSP + ((size_t)(b * 8 + h) * 128 + kidx) * 128 + v] = accS[mt2][nt][jj];
      }
}

__device__ __forceinline__ void dn_onorm_phase(const Params& p, unsigned char* lds) {
  const int tid = threadIdx.x;
  bf16_t* Ot = (bf16_t*)lds;
  float* red = (float*)(lds + 128 * 66 * 2);
  for (int it = blockIdx.x; it < 2048 + 128; it += gridDim.x) {
    if (it < 2048) {
      const int item = it, h = item & 7, n = (item >> 3) & 31, b = item >> 8, r0 = b * TSEQ + n * 64;
#pragma unroll
      for (int i = 0; i < 4; ++i) {
        const int q = tid + 256 * i, v = q >> 3, ch = q & 7;
        const u32x4 d = *(const u32x4*)(p.uT + (size_t)item * 8192 + v * 64 + ch * 8);
        unsigned* dst = (unsigned*)(Ot + v * 66 + ch * 8);
        dst[0] = d[0]; dst[1] = d[1]; dst[2] = d[2]; dst[3] = d[3];
      }
      __syncthreads();
      { const int i = tid & 63, vq = tid >> 6; float s = 0.f;
#pragma unroll 8
        for (int v = vq * 32; v < vq * 32 + 32; ++v) { const float o = bf2f(Ot[v * 66 + i]); s += o * o; }
        red[vq * 64 + i] = s; }
      __syncthreads();
      {
#pragma unroll
        for (int m = 0; m < 4; ++m) {
          const int q = tid + 256 * m, i = q >> 4, v8 = (q & 15) * 8;
          const float rs = rsqrtf((red[i] + red[64 + i] + red[128 + i] + red[192 + i]) * (1.f / 128.f) + 1e-6f);
          const size_t go = (size_t)(r0 + i) * DM + h * 128 + v8;
          const u32x4 zz = *(const u32x4*)(p.zb + go);
          const f32x4 w0 = *(const f32x4*)(p.dn_o_norm_w + v8), w1 = *(const f32x4*)(p.dn_o_norm_w + v8 + 4);
          float r[8];
#pragma unroll
          for (int j = 0; j < 8; ++j) {
            const float z = (j & 1) ? __uint_as_float(zz[j >> 1] & 0xffff0000u) : __uint_as_float(zz[j >> 1] << 16);
            r[j] = bf2f(Ot[(v8 + j) * 66 + i]) * rs * (j < 4 ? w0[j & 3] : w1[j & 3]) * silu_f(z);
          }
          *(u32x4*)(p.actA + go) = (u32x4){pk_bf16(r[0], r[1]), pk_bf16(r[2], r[3]), pk_bf16(r[4], r[5]), pk_bf16(r[6], r[7])};
        }
      }
      __syncthreads();
    } else {
      const int b = it - 2048; const int c = tid * 4;
      const f32x4 o = *(const f32x4*)(p.osamp + (size_t)b * DM + c);
      float s = o[0] * o[0] + o[1] * o[1] + o[2] * o[2] + o[3] * o[3];
#pragma unroll
      for (int m = 16; m >= 1; m >>= 1) s += __shfl_xor(s, m);
      const float rs = rsqrtf(s * (1.f / 128.f) + 1e-6f);
      const f32x4 ow = *(const f32x4*)(p.dn_o_norm_w + (c & 127));
      const size_t go = (size_t)(MP + b) * DM + c;
      const u32x2 zz = *(const u32x2*)(p.zb + go);
      const float z0 = __uint_as_float(zz[0] << 16), z1 = __uint_as_float(zz[0] & 0xffff0000u), z2 = __uint_as_float(zz[1] << 16), z3 = __uint_as_float(zz[1] & 0xffff0000u);
      *(u32x2*)(p.actA + go) = (u32x2){pk_bf16(o[0] * rs * ow[0] * silu_f(z0), o[1] * rs * ow[1] * silu_f(z1)), pk_bf16(o[2] * rs * ow[2] * silu_f(z2), o[3] * rs * ow[3] * silu_f(z3))};
    }
  }
}

#define XB_XCNT(j) (64 * (j))
#define XB_XSUB(j) (1024 + 64 * (j))
#define XB_XGEN(j) (2048 + 64 * (j))
#define XB_TOP     3072
#define XB_TOPGEN  3136
#define XB_WORDS   3200
#define XB_SPIN_CAP (1u << 24)
__device__ __forceinline__ unsigned xb_ld(unsigned* q) { return __hip_atomic_load(q, __ATOMIC_RELAXED, __HIP_MEMORY_SCOPE_AGENT); }
__device__ __forceinline__ unsigned xb_add(unsigned* q, unsigned v) { return __hip_atomic_fetch_add(q, v, __ATOMIC_RELAXED, __HIP_MEMORY_SCOPE_AGENT); }
__device__ __forceinline__ unsigned xb_xcc_id() { return (unsigned)__builtin_amdgcn_s_getreg((3 << 11) | 20) & 0xFu; }
struct XBar { unsigned* bar; unsigned x; volatile unsigned* st; };
__device__ __forceinline__ void grid_barrier(const XBar& b) {
  asm volatile("s_waitcnt vmcnt(0)" ::: "memory");
  __syncthreads();
  if (threadIdx.x == 0) {
    unsigned* bar = b.bar;
    unsigned nloc = b.st[0], nx = b.st[1];
    if (nloc == 0u) {
      const unsigned G = gridDim.x; unsigned sp = 0;
      for (;;) {
        unsigned sum = 0, cnt = 0, mine = 0;
#pragma unroll
        for (unsigned j = 0; j < 16; ++j) { const unsigned c = xb_ld(&bar[XB_XCNT(j)]); sum += c; cnt += (c > 0u) ? 1u : 0u; mine = (j == b.x) ? c : mine; }
        nloc = mine > 0u ? mine : 1u; nx = cnt > 0u ? cnt : 1u;
        if (sum == G || ++sp > XB_SPIN_CAP) break;
        __builtin_amdgcn_s_sleep(2);
      }
      b.st[0] = nloc; b.st[1] = nx;
    }
    const unsigned old = xb_add(&bar[XB_XSUB(b.x)], 1u);
    const unsigned gen = old / nloc;
    if (old + 1u == (gen + 1u) * nloc) {
      __builtin_amdgcn_fence(__ATOMIC_RELEASE, "agent");
      asm volatile("s_waitcnt vmcnt(0)" ::: "memory");
      const unsigned og = xb_add(&bar[XB_TOP], 1u);
      const unsigned tg = og / nx;
      if (og + 1u == (tg + 1u) * nx) xb_add(&bar[XB_TOPGEN], 1u);
      else { unsigned sp = 0; while (xb_ld(&bar[XB_TOPGEN]) == tg && ++sp < XB_SPIN_CAP) __builtin_amdgcn_s_sleep(2); }
      __builtin_amdgcn_fence(__ATOMIC_ACQUIRE, "agent");
      xb_add(&bar[XB_XGEN(b.x)], 1u);
      asm volatile("s_waitcnt vmcnt(0)" ::: "memory");
    } else {
      unsigned sp = 0; while (xb_ld(&bar[XB_XGEN(b.x)]) == gen && ++sp < XB_SPIN_CAP) __builtin_amdgcn_s_sleep(2);
      __builtin_amdgcn_fence(__ATOMIC_ACQUIRE, "agent");
      asm volatile("s_waitcnt vmcnt(0)" ::: "memory");
    }
  }
  __syncthreads();
}

constexpr int NPHASE = 16;
__global__ void __launch_bounds__(256, 2) mega(Params p) {
  __shared__ __attribute__((aligned(16))) unsigned char lds[LDS_BYTES + 16];
  cg::grid_group grid = cg::this_grid();
  if (p.phase_lo < 0) grid.sync();
  XBar xb; xb.bar = p.bar; xb.x = xb_xcc_id(); xb.st = (volatile unsigned*)(lds + LDS_BYTES);
  if (threadIdx.x == 0) { xb.st[0] = 0u; xb.st[1] = 0u; (void)xb_add(&p.bar[XB_XCNT(xb.x)], 1u); }
  __syncthreads();
#define PHASE(k, call) if (p.phase_lo <= (k) && (k) < p.phase_hi) { call; if ((k) + 1 < p.phase_hi) grid_barrier(xb); }
  PHASE(0, phase0(p, lds))
  PHASE(1, phase1(p))
  PHASE(2, gemm_rows_phase<0>(p, lds, p.actA, DM, p.WpoolT, 256, 1))
  PHASE(3, norm_to_bf16(p, p.norm2_w, 0))
  PHASE(4, ffn_up_phase(p, lds, 0))
  PHASE(5, gemm_rows_phase<1>(p, lds, p.act, DFF, p.WdnT0, DFF, 11))
  PHASE(6, norm_to_bf16(p, p.norm1_w + DM, 11))
  PHASE(7, dn_in_phase(p, lds))
  PHASE(8, dn_pre_phase(p, lds))
  PHASE(9, dn_scan_phase(p, lds))
  PHASE(10, dn_onorm_phase(p, lds))
  PHASE(11, gemm_rows_phase<1>(p, lds, p.actA, DM, p.WoutT, DM, 4))
  PHASE(12, norm_to_bf16(p, p.norm2_w + DM, 4))
  PHASE(13, ffn_up_phase(p, lds, 1))
  PHASE(14, gemm_rows_phase<1>(p, lds, p.act, DFF, p.WdnT1, DFF, 11))
  PHASE(15, final_norm(p, 11))
}

extern "C" void kernel_launch(void* const* d_in, const int* in_sizes, int n_in, void* d_out, int out_size, void* d_ws, size_t ws_size, hipStream_t stream) {
  static int grid_blocks = 0;
  if (!grid_blocks) {
    int dev = 0, cus = 0, per_cu = 0;
    hipGetDevice(&dev);
    hipDeviceGetAttribute(&cus, hipDeviceAttributeMultiprocessorCount, dev);
    hipOccupancyMaxActiveBlocksPerMultiprocessor(&per_cu, mega, 256, 0);
    if (per_cu > 2) per_cu = 2;
    grid_blocks = cus * per_cu;
    if (grid_blocks < 256 || (grid_blocks & 7)) fprintf(stderr, "unexpected grid %d\n", grid_blocks);
  }
  Params p{};
  const float* const* in = (const float* const*)d_in;
  p.xp = in[0]; p.xs = in[1]; p.st_pool = in[2]; p.st_dnc = in[3]; p.st_ssm = in[4]; p.st_ffn = in[5];
  p.norm1_w = in[6]; p.norm2_w = in[7]; p.final_w = in[8]; p.pool_w = in[9]; p.pool_scale = in[10]; p.dn_w_in = in[11]; p.dn_conv_w = in[12];
  p.dn_a_log = in[13]; p.dn_dt_bias = in[14]; p.dn_o_norm_w = in[15]; p.dn_w_out = in[16]; p.ffn_w_up = in[17]; p.ffn_conv_w = in[18]; p.ffn_conv_b = in[19]; p.ffn_w_down = in[20];
  p.out = (float*)d_out;
  unsigned char* ws = (unsigned char*)d_ws; size_t off = 0;
  auto take = [&](size_t bytes) { unsigned char* r = ws + off; off += (bytes + 255) & ~(size_t)255; return r; };
  unsigned char* w0 = take((size_t)4 * 65536 * 2 + (size_t)DFF2 * DM * 2 + (size_t)DM * DFF * 2);
  p.WpoolT = (bf16_t*)w0; p.WupT0 = (bf16_t*)(w0 + (size_t)4 * 65536 * 2); p.WdnT0 = (bf16_t*)(w0 + (size_t)4 * 65536 * 2 + (size_t)DFF2 * DM * 2);
  p.qkb = (bf16_t*)w0;
  p.WupT1 = (bf16_t*)take((size_t)DFF2 * DM * 2); p.WdnT1 = (bf16_t*)take((size_t)DM * DFF * 2);
  p.WinT = (bf16_t*)take((size_t)DNIN_PAD * DM * 2); p.WoutT = (bf16_t*)take((size_t)DM * DM * 2);
  p.bar = (unsigned*)take((size_t)XB_WORDS * 4);
  p.rstd = (float*)take((size_t)MTOT * 4); p.gbuf = (float*)take((size_t)MTOT * 8 * 4); p.betabuf = (float*)take((size_t)MTOT * 8 * 4);
  p.gcbuf = (float*)take((size_t)2048 * 64 * 4); p.osamp = (float*)take((size_t)MS * DM * 4); p.part = (float*)take((size_t)11 * MS * DM * 4);
  p.actA = (bf16_t*)take((size_t)MTOT * DM * 2); p.win = p.actA;
  unsigned char* big = take(0); const size_t big_off = off;
  p.act = (bf16_t*)big;
  const size_t bsz = (size_t)MTOT * DM * 2;
  p.qb = (bf16_t*)big; p.kb = (bf16_t*)(big + bsz); p.vb = (bf16_t*)(big + 2 * bsz); p.zb = (bf16_t*)(big + 3 * bsz); p.uT = (bf16_t*)(big + 4 * bsz);
  const size_t need = big_off + 4 * bsz + (size_t)2048 * 8192 * 2;
  if (need > ws_size || big_off + (size_t)MTOT * DFF * 2 > ws_size) { fprintf(stderr, "workspace too small: need %zu have %zu\n", need, ws_size); return; }
  p.phase_lo = 0; p.phase_hi = NPHASE;
  hipMemsetAsync(p.bar, 0, (size_t)XB_WORDS * 4, stream);
  void* args[] = {&p};
  hipError_t e = hipLaunchCooperativeKernel((void*)mega, dim3(grid_blocks), dim3(256), args, 0, stream);
  if (e != hipSuccess) fprintf(stderr, "cooperative launch failed: %s (grid %d)\n", hipGetErrorString(e), grid_blocks);
}
```

```cpp
#include <hip/hip_runtime.h>
#include <hip/hip_cooperative_groups.h>
#include <cstdio>
#include <cstdint>
namespace cg = cooperative_groups;

typedef unsigned short bf16_t;
typedef short bf16x8 __attribute__((ext_vector_type(8)));
typedef float f32x4 __attribute__((ext_vector_type(4)));
typedef unsigned u32x4 __attribute__((ext_vector_type(4)));
typedef unsigned u32x2 __attribute__((ext_vector_type(2)));

constexpr int DM = 1024, TSEQ = 2048, NBP = 8, MP = 16384, MS = 128, MTOT = 16512;
constexpr int DFF = 2816, DFF2 = 5632, DNIN = 4112, DNIN_PAD = 4224;
constexpr int LDS_BYTES = 69632;
constexpr int TLD = 132;
constexpr size_t O_YP = 0, O_YS = O_YP + (size_t)MP * DM, O_POOLP = O_YS + (size_t)MS * DM, O_POOLS = O_POOLP + (size_t)NBP * 15 * DM,
                 O_DNCP = O_POOLS + (size_t)MS * 15 * DM, O_DNCS = O_DNCP + (size_t)NBP * 3 * 3072, O_DNSP = O_DNCS + (size_t)MS * 3 * 3072,
                 O_DNSS = O_DNSP + (size_t)NBP * 8 * 128 * 128, O_FFNP = O_DNSS + (size_t)MS * 8 * 128 * 128, O_FFNS = O_FFNP + (size_t)2 * NBP * 2 * DFF2;

struct Params {
  const float *xp, *xs, *st_pool, *st_dnc, *st_ssm, *st_ffn;
  const float *norm1_w, *norm2_w, *final_w, *pool_w, *pool_scale, *dn_w_in, *dn_conv_w, *dn_a_log, *dn_dt_bias, *dn_o_norm_w, *dn_w_out,
      *ffn_w_up, *ffn_conv_w, *ffn_conv_b, *ffn_w_down;
  float* out;
  bf16_t *WpoolT, *WupT0, *WupT1, *WdnT0, *WdnT1, *WinT, *WoutT;
  bf16_t *actA, *act, *qb, *kb, *vb, *zb, *uT, *win, *qkb;
  float *rstd, *gbuf, *betabuf, *gcbuf, *osamp, *part;
  unsigned* bar;
  int phase_lo, phase_hi;
};

__device__ __forceinline__ float bf2f(bf16_t b) { return __uint_as_float(((unsigned)b) << 16); }
typedef float f32x2 __attribute__((ext_vector_type(2)));
typedef __bf16 bf16x2_t __attribute__((ext_vector_type(2)));
__device__ __forceinline__ unsigned pk_bf16(float lo, float hi) { const f32x2 v = {lo, hi}; const bf16x2_t b = __builtin_convertvector(v, bf16x2_t); return __builtin_bit_cast(unsigned, b); }
__device__ __forceinline__ bf16_t f2bf(float x) { return (bf16_t)(pk_bf16(x, 0.f) & 0xffffu); }
template <int CTRL> __device__ __forceinline__ float dpp_add(float v) {
  return v + __builtin_bit_cast(float, __builtin_amdgcn_update_dpp(0, __builtin_bit_cast(int, v), CTRL, 0xF, 0xF, true));
}
__device__ __forceinline__ float wave_sum(float v) {
  v = dpp_add<0xB1>(v);
  v = dpp_add<0x4E>(v);
  v = dpp_add<0x141>(v);
  v = dpp_add<0x140>(v);
  const int vi = __builtin_bit_cast(int, v);
  const float r0 = __builtin_bit_cast(float, __builtin_amdgcn_readlane(vi, 0)), r1 = __builtin_bit_cast(float, __builtin_amdgcn_readlane(vi, 16));
  const float r2 = __builtin_bit_cast(float, __builtin_amdgcn_readlane(vi, 32)), r3 = __builtin_bit_cast(float, __builtin_amdgcn_readlane(vi, 48));
  return (r0 + r1) + (r2 + r3);
}
__device__ __forceinline__ float silu_f(float x) { return x * __builtin_amdgcn_rcpf(1.f + __expf(-x)); }
__device__ __forceinline__ f32x4 mfma16(bf16x8 a, bf16x8 b, f32x4 c) { return __builtin_amdgcn_mfma_f32_16x16x32_bf16(a, b, c, 0, 0, 0); }

#define LAS __attribute__((address_space(3)))
__device__ __forceinline__ void gemm_mainloop(unsigned char* lds, const bf16_t* __restrict__ A, int lda, const int (&arow)[4], int acol0,
                                              const bf16_t* __restrict__ Bt, int ldb, int n0, int bcol0, int K, f32x4 (&acc)[4][4]) {
  const int tid = threadIdx.x, lane = tid & 63, w = tid >> 6, wm = w >> 1, wn = w & 1, r16 = lane & 15, quad = lane >> 4;
  const int lrow = tid >> 3;
  const int chl = (tid & 7) ^ ((lrow >> 1) & 7);
  const bf16_t* pa[4]; const bf16_t* pb[4];
#pragma unroll
  for (int i = 0; i < 4; ++i) { pa[i] = A + (size_t)arow[i] * lda + acol0 + chl * 8; pb[i] = Bt + (size_t)(n0 + lrow + 32 * i) * ldb + bcol0 + chl * 8; }
  LAS unsigned char* sA = (LAS unsigned char*)lds; LAS unsigned char* sB = sA + 32768;
  const unsigned wbase = (unsigned)__builtin_amdgcn_readfirstlane(w) * 1024u;
#pragma unroll
  for (int mi = 0; mi < 4; ++mi)
#pragma unroll
    for (int ni = 0; ni < 4; ++ni) acc[mi][ni] = (f32x4){0.f, 0.f, 0.f, 0.f};
#pragma unroll
  for (int i = 0; i < 4; ++i) {
    __builtin_amdgcn_global_load_lds((const unsigned*)pa[i], (LAS unsigned*)(sA + wbase + i * 4096), 16, 0, 0);
    __builtin_amdgcn_global_load_lds((const unsigned*)pb[i], (LAS unsigned*)(sB + wbase + i * 4096), 16, 0, 0);
  }
  __syncthreads();
  const int nk = K >> 6;
  const unsigned a_rd = (wm * 64 + r16) * 128, b_rd = (wn * 64 + r16) * 128; const int sw = r16 >> 1;
  for (int kt = 0; kt < nk; ++kt) {
    const int cur = kt & 1;
    const LAS unsigned char* cA = sA + cur * 16384 + a_rd; const LAS unsigned char* cB = sB + cur * 16384 + b_rd;
    {
      bf16x8 af[2][4], bfr[2][4];
#pragma unroll
      for (int ks = 0; ks < 2; ++ks) {
        const unsigned co = (unsigned)(((ks * 4 + quad) ^ sw) << 4);
#pragma unroll
        for (int mi = 0; mi < 4; ++mi) af[ks][mi] = *(const LAS bf16x8*)(cA + mi * 2048 + co);
#pragma unroll
        for (int ni = 0; ni < 4; ++ni) bfr[ks][ni] = *(const LAS bf16x8*)(cB + ni * 2048 + co);
      }
      if (kt + 1 < nk) {
        const int k0 = (kt + 1) << 6;
#pragma unroll
        for (int i = 0; i < 4; ++i) {
          __builtin_amdgcn_global_load_lds((const unsigned*)(pa[i] + k0), (LAS unsigned*)(sA + (cur ^ 1) * 16384 + wbase + i * 4096), 16, 0, 0);
          __builtin_amdgcn_global_load_lds((const unsigned*)(pb[i] + k0), (LAS unsigned*)(sB + (cur ^ 1) * 16384 + wbase + i * 4096), 16, 0, 0);
        }
      }
      __builtin_amdgcn_s_setprio(1);
#pragma unroll
      for (int ks = 0; ks < 2; ++ks)
#pragma unroll
        for (int mi = 0; mi < 4; ++mi)
#pragma unroll
          for (int ni = 0; ni < 4; ++ni) acc[mi][ni] = mfma16(bfr[ks][ni], af[ks][mi], acc[mi][ni]);
      __builtin_amdgcn_s_setprio(0);
    }
    __syncthreads();
  }
}

__device__ __forceinline__ void acc_to_lds(unsigned char* lds, const f32x4 (&acc)[4][4]) {
  const int tid = threadIdx.x, lane = tid & 63, w = tid >> 6, wm = w >> 1, wn = w & 1, r16 = lane & 15, quad = lane >> 4;
  float* T = (float*)lds;
#pragma unroll
  for (int mi = 0; mi < 4; ++mi)
#pragma unroll
    for (int ni = 0; ni < 4; ++ni) *(f32x4*)(T + (wm * 64 + mi * 16 + r16) * TLD + wn * 64 + ni * 16 + quad * 4) = acc[mi][ni];
}

__device__ __forceinline__ int unit_linear(int u, int G, int total) {
  const int base = (u / G) * G;
  if (base + G > total) return u;
  const int x = u & 7, v = (u % G) >> 3; return base + x * (G >> 3) + v;
}
__device__ __forceinline__ bool unit_decode(int L, int nRT, int nCT, int& rt, int& ct) {
  const int per = 8 * nCT; const int sg = L / per; const int rem = L - sg * per; ct = rem >> 3; rt = sg * 8 + (rem & 7);
  return rt < nRT;
}

__device__ __forceinline__ void transpose_tile(unsigned char* lds, const float* __restrict__ src, int ld_src, int k0, int nsrc0, int nvalid, bf16_t* __restrict__ dst, int ld_dst, int ndst0) {
  float* T = (float*)lds;
  const int tid = threadIdx.x;
  f32x4 v[4];
#pragma unroll
  for (int m = 0; m < 4; ++m) {
    const int q = tid + 256 * m, k = q >> 4, n4 = (q & 15) * 4;
    const float* sp = src + (size_t)(k0 + k) * ld_src + nsrc0 + n4;
    if (n4 + 3 < nvalid) v[m] = *(const f32x4*)sp;
    else { v[m] = (f32x4){0.f, 0.f, 0.f, 0.f};
#pragma unroll
      for (int j = 0; j < 4; ++j) if (n4 + j < nvalid) v[m][j] = sp[j]; }
  }
#pragma unroll
  for (int m = 0; m < 4; ++m) { const int q = tid + 256 * m, k = q >> 4, n4 = (q & 15) * 4; *(f32x4*)(T + k * 68 + n4) = v[m]; }
  __syncthreads();
  const int n = tid >> 2, kseg = (tid & 3) * 16;
  unsigned pk[8];
#pragma unroll
  for (int i = 0; i < 8; ++i) pk[i] = pk_bf16(T[(kseg + 2 * i) * 68 + n], T[(kseg + 2 * i + 1) * 68 + n]);
  bf16_t* d = dst + (size_t)(ndst0 + n) * ld_dst + k0 + kseg;
  *(u32x4*)(d) = (u32x4){pk[0], pk[1], pk[2], pk[3]};
  *(u32x4*)(d + 8) = (u32x4){pk[4], pk[5], pk[6], pk[7]};
  __syncthreads();
}

__device__ __forceinline__ void rstd_rows(const Params& p) {
  const int lane = threadIdx.x & 63; const int gw = (blockIdx.x * 256 + threadIdx.x) >> 6, nw = gridDim.x * 4;
  for (int r = gw; r < MTOT; r += nw) {
    const float* x = (r < MP) ? p.xp + (size_t)r * DM : p.xs + (size_t)(r - MP) * DM;
    float s = 0.f;
#pragma unroll
    for (int m = 0; m < 4; ++m) { const f32x4 v = *(const f32x4*)(x + lane * 4 + 256 * m); s += v[0] * v[0] + v[1] * v[1] + v[2] * v[2] + v[3] * v[3]; }
    s = wave_sum(s);
    if (lane == 0) p.rstd[r] = rsqrtf(s * (1.f / DM) + 1e-6f);
  }
}

__device__ __forceinline__ void phase0(const Params& p, unsigned char* lds) {
  for (int job = blockIdx.x; job < 5600; job += gridDim.x) {
    int j = job;
    if (j < 64) { const int g = j >> 4, t = j & 15, kt = t >> 2, nt = t & 3;
      transpose_tile(lds, p.pool_w + (size_t)g * 65536, 256, kt * 64, nt * 64, 64, p.WpoolT + (size_t)g * 65536, 256, nt * 64); continue; }
    j -= 64;
    if (j < 2816) { const int layer = j / 1408, t = j % 1408, kt = t / 88, nb = t % 88;
      const int ct = nb >> 1, isval = nb & 1; const int nsrc0 = isval ? DFF + ct * 64 : ct * 64;
      transpose_tile(lds, p.ffn_w_up + (size_t)layer * DM * DFF2, DFF2, kt * 64, nsrc0, 64, layer ? p.WupT1 : p.WupT0, DM, nb * 64); continue; }
    j -= 2816;
    if (j < 1408) { const int layer = j / 704, t = j % 704, kt = t / 16, nb = t % 16;
      transpose_tile(lds, p.ffn_w_down + (size_t)layer * DFF * DM, DM, kt * 64, nb * 64, 64, layer ? p.WdnT1 : p.WdnT0, DFF, nb * 64); continue; }
    j -= 1408;
    if (j < 1056) { const int kt = j / 66, nb = j % 66; const int nv = (DNIN - nb * 64) < 0 ? 0 : ((DNIN - nb * 64) > 64 ? 64 : (DNIN - nb * 64));
      transpose_tile(lds, p.dn_w_in, DNIN, kt * 64, nb * 64, nv, p.WinT, DM, nb * 64); continue; }
    j -= 1056;
    { const int kt = j >> 4, nb = j & 15; transpose_tile(lds, p.dn_w_out, DM, kt * 64, nb * 64, 64, p.WoutT, DM, nb * 64); }
  }
  rstd_rows(p);
  const size_t gt = (size_t)blockIdx.x * 256 + threadIdx.x, gn = (size_t)gridDim.x * 256;
  for (size_t i = gt; i < (size_t)MS * 14 * 256; i += gn) {
    const size_t c4 = i & 255, r = (i >> 8) % 14, b = (i >> 8) / 14;
    *(f32x4*)(p.out + O_POOLS + (b * 15 + r) * DM + c4 * 4) = *(const f32x4*)(p.st_pool + (b * 15 + r + 1) * DM + c4 * 4);
  }
  for (size_t i = gt; i < (size_t)MS * 2 * 768; i += gn) {
    const size_t c4 = i % 768, r = (i / 768) & 1, b = i / 1536;
    *(f32x4*)(p.out + O_DNCS + (b * 3 + r) * 3072 + c4 * 4) = *(const f32x4*)(p.st_dnc + (b * 3 + r + 1) * 3072 + c4 * 4);
  }
  for (size_t i = gt; i < (size_t)2 * MS * 1408; i += gn) {
    const size_t c4 = i % 1408, lb = i / 1408;
    *(f32x4*)(p.out + O_FFNS + (lb * 2 + 0) * DFF2 + c4 * 4) = *(const f32x4*)(p.st_ffn + (lb * 2 + 1) * DFF2 + c4 * 4);
  }
}

__device__ __forceinline__ void phase1(const Params& p) {
  const int gt = blockIdx.x * 256 + threadIdx.x, gn = gridDim.x * 256;
  const float* w1 = p.norm1_w;
  for (int idx = gt; idx < 1024 * 256; idx += gn) {
    const int f4 = idx & 255, strip = idx >> 8, b = strip >> 7, t0 = (strip & 127) * 16, c = f4 * 4, g = f4 >> 6, win = 2 << g;
    const f32x4 wv = *(const f32x4*)(w1 + c);
    const float* xb = p.xp + (size_t)b * TSEQ * DM + c; const float* rs = p.rstd + b * TSEQ;
    f32x4 s = (f32x4){0.f, 0.f, 0.f, 0.f};
    for (int j = 1; j < win; ++j) { const int t = t0 - j; if (t >= 0) s += *(const f32x4*)(xb + (size_t)t * DM) * rs[t] * wv; }
    for (int tt = 0; tt < 16; ++tt) {
      const int t = t0 + tt;
      const f32x4 ht = *(const f32x4*)(xb + (size_t)t * DM) * rs[t] * wv;
      s += ht;
      const int cnt = (t + 1 < win) ? (t + 1) : win;
      const f32x4 dgv = s * __builtin_amdgcn_rcpf((float)cnt) - ht;
      *(u32x2*)(p.actA + (size_t)(b * TSEQ + t) * DM + c) = (u32x2){pk_bf16(dgv[0], dgv[1]), pk_bf16(dgv[2], dgv[3])};
      if (t >= TSEQ - 15) *(f32x4*)(p.out + O_POOLP + ((size_t)b * 15 + (t - (TSEQ - 15))) * DM + c) = ht;
      const int to = t - win + 1;
      if (to >= 0) s -= *(const f32x4*)(xb + (size_t)to * DM) * rs[to] * wv;
    }
  }
  for (int idx = gt; idx < MS * 256; idx += gn) {
    const int f4 = idx & 255, b = idx >> 8, c = f4 * 4, g = f4 >> 6, win = 2 << g;
    const f32x4 wv = *(const f32x4*)(w1 + c);
    const f32x4 ht = *(const f32x4*)(p.xs + (size_t)b * DM + c) * p.rstd[MP + b] * wv;
    f32x4 s = ht;
    for (int j = 1; j < win; ++j) s += *(const f32x4*)(p.st_pool + ((size_t)b * 15 + (15 - j)) * DM + c);
    const f32x4 dgv = s * __builtin_amdgcn_rcpf((float)win) - ht;
    *(u32x2*)(p.actA + (size_t)(MP + b) * DM + c) = (u32x2){pk_bf16(dgv[0], dgv[1]), pk_bf16(dgv[2], dgv[3])};
    *(f32x4*)(p.out + O_POOLS + ((size_t)b * 15 + 14) * DM + c) = ht;
  }
}

template <int MODE>
__device__ __forceinline__ void gemm_rows_phase(const Params& p, unsigned char* lds, const bf16_t* A, int lda, const bf16_t* Bt, int K, int ksplit) {
  const int G = gridDim.x, nCT = 8;
  const int nRT = (MODE == 0) ? MTOT / 128 : MP / 128;
  const int nmain = ((nRT + 7) / 8) * 8 * nCT, total = nmain + ((MODE == 0) ? 0 : 8 * ksplit);
  const int tid = threadIdx.x, lane = tid & 63, w = tid >> 6, wm = w >> 1, wn = w & 1, r16 = lane & 15, quad = lane >> 4;
  const int nround = (total + G - 1) / G;
  for (int rd = 0; rd < nround; ++rd) {
    const int L = unit_linear(rd * G + blockIdx.x, G, total);
    int rt, ct, kofs = 0, klen = K; bool sub = false;
    if (L >= total) continue;
    if (L < nmain) { if (!unit_decode(L, nRT, nCT, rt, ct)) continue; }
    else { const int idx = L - nmain; ct = idx & 7; rt = MP / 128; klen = K / ksplit; kofs = (idx >> 3) * klen; sub = true; }
    int arow[4];
#pragma unroll
    for (int i = 0; i < 4; ++i) arow[i] = rt * 128 + (tid >> 3) + 32 * i;
    f32x4 acc[4][4];
    if (MODE == 0) gemm_mainloop(lds, A, lda, arow, (ct >> 1) * 256, Bt + (size_t)(ct >> 1) * 65536, 256, (ct & 1) * 128, 0, 256, acc);
    else gemm_mainloop(lds, A, lda, arow, kofs, Bt, K, ct * 128, kofs, klen, acc);
#pragma unroll
    for (int mi = 0; mi < 4; ++mi) {
      const int row = rt * 128 + wm * 64 + mi * 16 + r16;
      float* orow = p.out + (size_t)row * DM;
#pragma unroll
      for (int ni = 0; ni < 4; ++ni) {
        const int col = ct * 128 + wn * 64 + ni * 16 + quad * 4;
        if (MODE == 0) {
          const float* xin = (row < MP) ? p.xp + (size_t)row * DM : p.xs + (size_t)(row - MP) * DM;
          *(f32x4*)(orow + col) = *(const f32x4*)(xin + col) + acc[mi][ni] * *(const f32x4*)(p.pool_scale + col);
        } else if (!sub) {
          *(f32x4*)(orow + col) = *(const f32x4*)(orow + col) + acc[mi][ni];
        } else {
#pragma unroll
          for (int j = 0; j < 4; ++j) (void)0;
          *(f32x4*)(p.part + ((size_t)(kofs / klen) * MS + (row - MP)) * DM + col) = acc[mi][ni];
        }
      }
    }
  }
}

__device__ __forceinline__ void norm_load_row(const Params& p, int r, int lane, int npart, f32x4 (&v)[4]) {
  const float* x = p.out + (size_t)r * DM;
#pragma unroll
  for (int m = 0; m < 4; ++m) v[m] = *(const f32x4*)(x + lane * 4 + 256 * m);
  if (r >= MP) {
    const float* part = p.part; asm volatile("" : "+v"(part));
    for (int k = 0; k < npart; ++k)
#pragma unroll
      for (int m = 0; m < 4; ++m) v[m] += *(const f32x4*)(part + ((size_t)k * MS + (r - MP)) * DM + lane * 4 + 256 * m);
  }
}
__device__ __forceinline__ void norm_to_bf16(const Params& p, const float* wgt, int npart) {
  const int lane = threadIdx.x & 63; const int gw = (blockIdx.x * 256 + threadIdx.x) >> 6, nw = gridDim.x * 4;
  f32x4 wv[4];
#pragma unroll
  for (int m = 0; m < 4; ++m) wv[m] = *(const f32x4*)(wgt + lane * 4 + 256 * m);
  f32x4 v[4], vn[4];
  if (gw < MTOT) norm_load_row(p, gw, lane, npart, v);
  for (int r = gw; r < MTOT; r += nw) {
    const bool more = r + nw < MTOT;
    if (more) norm_load_row(p, r + nw, lane, npart, vn);
    float s = 0.f;
#pragma unroll
    for (int m = 0; m < 4; ++m) s += v[m][0] * v[m][0] + v[m][1] * v[m][1] + v[m][2] * v[m][2] + v[m][3] * v[m][3];
    s = wave_sum(s);
    const float rs = rsqrtf(s * (1.f / DM) + 1e-6f);
    if (r >= MP && npart > 0) {
#pragma unroll
      for (int m = 0; m < 4; ++m) *(f32x4*)(p.out + (size_t)r * DM + lane * 4 + 256 * m) = v[m];
    }
#pragma unroll
    for (int m = 0; m < 4; ++m) { const f32x4 o = v[m] * rs * wv[m];
      *(u32x2*)(p.actA + (size_t)r * DM + lane * 4 + 256 * m) = (u32x2){pk_bf16(o[0], o[1]), pk_bf16(o[2], o[3])}; }
    if (more) {
#pragma unroll
      for (int m = 0; m < 4; ++m) v[m] = vn[m];
    }
  }
}
__device__ __forceinline__ void final_norm(const Params& p, int npart) {
  const int lane = threadIdx.x & 63; const int gw = (blockIdx.x * 256 + threadIdx.x) >> 6, nw = gridDim.x * 4;
  f32x4 wv[4];
#pragma unroll
  for (int m = 0; m < 4; ++m) wv[m] = *(const f32x4*)(p.final_w + lane * 4 + 256 * m);
  f32x4 v[4], vn[4];
  if (gw < MTOT) norm_load_row(p, gw, lane, npart, v);
  for (int r = gw; r < MTOT; r += nw) {
    const bool more = r + nw < MTOT;
    if (more) norm_load_row(p, r + nw, lane, npart, vn);
    float s = 0.f;
#pragma unroll
    for (int m = 0; m < 4; ++m) s += v[m][0] * v[m][0] + v[m][1] * v[m][1] + v[m][2] * v[m][2] + v[m][3] * v[m][3];
    s = wave_sum(s);
    const float rs = rsqrtf(s * (1.f / DM) + 1e-6f);
#pragma unroll
    for (int m = 0; m < 4; ++m) *(f32x4*)(p.out + (size_t)r * DM + lane * 4 + 256 * m) = v[m] * rs * wv[m];
    if (more) {
#pragma unroll
      for (int m = 0; m < 4; ++m) v[m] = vn[m];
    }
  }
}

__device__ __forceinline__ void ffn_up_phase(const Params& p, unsigned char* lds, int layer) {
  const int G = gridDim.x, nRTp = NBP * 17, nCT = 44, nmainp = nRTp * nCT, total = nmainp + nCT;
  const int tid = threadIdx.x;
  const bf16_t* Bt = layer ? p.WupT1 : p.WupT0;
  const float* cw = p.ffn_conv_w + (size_t)layer * 3 * DFF2; const float* cb = p.ffn_conv_b + (size_t)layer * DFF2;
  const int nround = (total + G - 1) / G;
  for (int rd = 0; rd < nround; ++rd) {
    const int L = unit_linear(rd * G + blockIdx.x, G, total);
    int rt, ct;
    if (L >= total) continue;
    if (L < nmainp) unit_decode(L, nRTp, nCT, rt, ct); else { rt = nRTp; ct = L - nmainp; }
    const bool samp = (rt == NBP * 17);
    const int b = rt / 17, ti = rt % 17, tbase = 126 * ti - 2;
    int arow[4];
#pragma unroll
    for (int i = 0; i < 4; ++i) { const int l = (tid >> 3) + 32 * i; int t = tbase + l; t = t < 0 ? 0 : (t > TSEQ - 1 ? TSEQ - 1 : t); arow[i] = samp ? MP + l : b * TSEQ + t; }
    f32x4 acc[4][4];
    gemm_mainloop(lds, p.actA, DM, arow, 0, Bt, DM, ct * 128, 0, DM, acc);
    acc_to_lds(lds, acc);
    __syncthreads();
    const float* T = (const float*)lds;
    const int cc = tid & 63, strip = tid >> 6, l0 = strip * 32;
    const int gcol = ct * 64 + cc, vcol = DFF + ct * 64 + cc;
    const float wg0 = cw[gcol], wg1 = cw[DFF2 + gcol], wg2 = cw[2 * DFF2 + gcol], bg = cb[gcol];
    const float wv0 = cw[vcol], wv1 = cw[DFF2 + vcol], wv2 = cw[2 * DFF2 + vcol], bv = cb[vcol];
    if (!samp) {
      const int c2 = (tid & 31) * 2, l0b = (tid >> 5) * 16, ls = l0b < 2 ? 2 : l0b;
      const int gc2 = ct * 64 + c2, vc2 = DFF + ct * 64 + c2;
      typedef float f32x2v __attribute__((ext_vector_type(2)));
      const f32x2v Wg0 = *(const f32x2v*)(cw + gc2), Wg1 = *(const f32x2v*)(cw + DFF2 + gc2), Wg2 = *(const f32x2v*)(cw + 2 * DFF2 + gc2), Bg = *(const f32x2v*)(cb + gc2);
      const f32x2v Wv0 = *(const f32x2v*)(cw + vc2), Wv1 = *(const f32x2v*)(cw + DFF2 + vc2), Wv2 = *(const f32x2v*)(cw + 2 * DFF2 + vc2), Bv = *(const f32x2v*)(cb + vc2);
      f32x2v G2 = *(const f32x2v*)(T + (ls - 2) * TLD + c2), G1 = *(const f32x2v*)(T + (ls - 1) * TLD + c2);
      f32x2v V2 = *(const f32x2v*)(T + (ls - 2) * TLD + 64 + c2), V1 = *(const f32x2v*)(T + (ls - 1) * TLD + 64 + c2);
      if (tbase + ls - 2 < 0) { G2 = (f32x2v){0.f, 0.f}; V2 = G2; }
      if (tbase + ls - 1 < 0) { G1 = (f32x2v){0.f, 0.f}; V1 = G1; }
      for (int l = ls; l < l0b + 16; ++l) {
        const int t = tbase + l; if (t >= TSEQ) break;
        const f32x2v G0 = *(const f32x2v*)(T + l * TLD + c2), V0 = *(const f32x2v*)(T + l * TLD + 64 + c2);
        const f32x2v cg = G2 * Wg0 + G1 * Wg1 + G0 * Wg2 + Bg, cv = V2 * Wv0 + V1 * Wv1 + V0 * Wv2 + Bv;
        *(unsigned*)(p.act + (size_t)(b * TSEQ + t) * DFF + ct * 64 + c2) = pk_bf16(silu_f(cg[0]) * cv[0], silu_f(cg[1]) * cv[1]);
        if (t >= TSEQ - 2) { float* o = p.out + O_FFNP + ((size_t)(layer * NBP + b) * 2 + (t - (TSEQ - 2))) * DFF2; *(f32x2v*)(o + gc2) = G0; *(f32x2v*)(o + vc2) = V0; }
        G2 = G1; G1 = G0; V2 = V1; V1 = V0;
      }
    } else {
      for (int l = l0; l < l0 + 32; ++l) {
        const float g0 = T[l * TLD + cc], v0 = T[l * TLD + 64 + cc];
        const float* st = p.st_ffn + (size_t)(layer * MS + l) * 2 * DFF2;
        const float cgt = st[gcol] * wg0 + st[DFF2 + gcol] * wg1 + g0 * wg2 + bg, cvl = st[vcol] * wv0 + st[DFF2 + vcol] * wv1 + v0 * wv2 + bv;
        p.act[(size_t)(MP + l) * DFF + ct * 64 + cc] = f2bf(silu_f(cgt) * cvl);
        float* o = p.out + O_FFNS + ((size_t)(layer * MS + l) * 2 + 1) * DFF2; o[gcol] = g0; o[vcol] = v0;
      }
    }
    __syncthreads();
  }
}

__device__ __forceinline__ void dn_in_phase(const Params& p, unsigned char* lds) {
  const int G = gridDim.x, nRTp = NBP * 17, nCT = 33, nmainp = nRTp * nCT, total = nmainp + nCT;
  const int tid = threadIdx.x, lane = tid & 63, w = tid >> 6;
  const int nround = (total + G - 1) / G;
  for (int rd = 0; rd < nround; ++rd) {
    const int L = unit_linear(rd * G + blockIdx.x, G, total);
    int rt, ct;
    if (L >= total) continue;
    if (L < nmainp) unit_decode(L, nRTp, nCT, rt, ct); else { rt = nRTp; ct = L - nmainp; }
    const bool samp = (rt == NBP * 17);
    const int b = rt / 17, ti = rt % 17, tbase = 125 * ti - 3;
    int arow[4];
#pragma unroll
    for (int i = 0; i < 4; ++i) { const int l = (tid >> 3) + 32 * i; int t = tbase + l; t = t < 0 ? 0 : (t > TSEQ - 1 ? TSEQ - 1 : t); arow[i] = samp ? MP + l : b * TSEQ + t; }
    f32x4 acc[4][4];
    gemm_mainloop(lds, p.actA, DM, arow, 0, p.WinT, DM, ct * 128, 0, DM, acc);
    acc_to_lds(lds, acc);
    __syncthreads();
    const float* T = (const float*)lds;
    const int l0 = w * 32;
    if (ct < 24) {
      const int c0 = lane * 2, c1 = lane * 2 + 1, col0 = ct * 128 + c0, col1 = ct * 128 + c1;
      const float* cw = p.dn_conv_w;
      const float a0 = cw[col0], a1 = cw[3072 + col0], a2 = cw[2 * 3072 + col0], a3 = cw[3 * 3072 + col0];
      const float e0 = cw[col1], e1 = cw[3072 + col1], e2 = cw[2 * 3072 + col1], e3 = cw[3 * 3072 + col1];
      bf16_t* dst = (ct < 8) ? p.qb : (ct < 16 ? p.kb : p.vb);
      const int hc = (ct & 7) * 128;
      const float post = (ct < 8) ? 0.08838834764831845f : 1.f;
      if (!samp) {
        const int ls = l0 < 3 ? 3 : l0;
        float x3 = T[(ls - 3) * TLD + c0], x2 = T[(ls - 2) * TLD + c0], x1 = T[(ls - 1) * TLD + c0];
        float y3 = T[(ls - 3) * TLD + c1], y2 = T[(ls - 2) * TLD + c1], y1 = T[(ls - 1) * TLD + c1];
        if (tbase + ls - 3 < 0) { x3 = 0.f; y3 = 0.f; }
        if (tbase + ls - 2 < 0) { x2 = 0.f; y2 = 0.f; }
        if (tbase + ls - 1 < 0) { x1 = 0.f; y1 = 0.f; }
        for (int l = ls; l < l0 + 32; ++l) {
          const int t = tbase + l; if (t >= TSEQ) break;
          const float x0 = T[l * TLD + c0], y0 = T[l * TLD + c1];
          float s0 = silu_f(x3 * a0 + x2 * a1 + x1 * a2 + x0 * a3), s1 = silu_f(y3 * e0 + y2 * e1 + y1 * e2 + y0 * e3);
          if (ct < 16) { const float ss = wave_sum(s0 * s0 + s1 * s1); const float sc = rsqrtf(ss + 1e-6f) * post; s0 *= sc; s1 *= sc; }
          bf16_t* d = dst + (size_t)(b * TSEQ + t) * DM + hc;
          *(unsigned*)(d + c0) = pk_bf16(s0, s1);
          if (t >= TSEQ - 3) { float* o = p.out + O_DNCP + ((size_t)b * 3 + (t - (TSEQ - 3))) * 3072; *(f32x2*)(o + col0) = (f32x2){x0, y0}; }
          x3 = x2; x2 = x1; x1 = x0; y3 = y2; y2 = y1; y1 = y0;
        }
      } else {
        for (int l = l0; l < l0 + 32; ++l) {
          const float x0 = T[l * TLD + c0], y0 = T[l * TLD + c1];
          const float* st = p.st_dnc + (size_t)l * 3 * 3072;
          float s0 = silu_f(st[col0] * a0 + st[3072 + col0] * a1 + st[2 * 3072 + col0] * a2 + x0 * a3);
          float s1 = silu_f(st[col1] * e0 + st[3072 + col1] * e1 + st[2 * 3072 + col1] * e2 + y0 * e3);
          if (ct < 16) { const float ss = wave_sum(s0 * s0 + s1 * s1); const float sc = rsqrtf(ss + 1e-6f) * post; s0 *= sc; s1 *= sc; }
          bf16_t* d = dst + (size_t)(MP + l) * DM + hc;
          *(unsigned*)(d + c0) = pk_bf16(s0, s1);
          float* o = p.out + O_DNCS + ((size_t)l * 3 + 2) * 3072; *(f32x2*)(o + col0) = (f32x2){x0, y0};
        }
      }
    } else if (ct < 32) {
      const int hc = (ct - 24) * 128;
      for (int l = l0; l < l0 + 32; ++l) {
        int row;
        if (samp) row = MP + l; else { const int t = tbase + l; if (l < 3 || t >= TSEQ) continue; row = b * TSEQ + t; }
        bf16_t* d = p.zb + (size_t)row * DM + hc;
        *(unsigned*)(d + 2 * lane) = pk_bf16(T[l * TLD + 2 * lane], T[l * TLD + 2 * lane + 1]);
      }
    } else {
      const int l = tid & 127, part = tid >> 7;
      int row = -1;
      if (samp) row = MP + l; else { const int t = tbase + l; if (l >= 3 && t < TSEQ) row = b * TSEQ + t; }
      if (row >= 0) {
#pragma unroll
        for (int hh = 0; hh < 8; ++hh) {
          if (part == 0) { const float a = T[l * TLD + hh] + p.dn_dt_bias[hh]; const float sp = (a > 0.f ? a : 0.f) + log1pf(__expf(-fabsf(a)));
            p.gbuf[(size_t)row * 8 + hh] = -__expf(p.dn_a_log[hh]) * sp; }
          else { const float bb = T[l * TLD + 8 + hh]; p.betabuf[(size_t)row * 8 + hh] = __builtin_amdgcn_rcpf(1.f + __expf(-bb)); }
        }
      }
    }
    __syncthreads();
  }
}

__device__ __forceinline__ unsigned img256(int row, int c) { return (unsigned)(row * 256 + ((((c >> 3) ^ (row & 15))) << 4) + (c & 7) * 2); }
__device__ __forceinline__ unsigned img128(int row, int c) { return (unsigned)(row * 128 + ((((c >> 3) ^ ((row >> 1) & 7))) << 4) + (c & 7) * 2); }

__device__ __forceinline__ void dn_chunk_item(const Params& p, unsigned char* lds, int item) {
  const int tid = threadIdx.x, lane = tid & 63, w = tid >> 6, r16 = lane & 15, quad = lane >> 4;
  const int h = item & 7, n = (item >> 3) & 31, b = item >> 8;
  const int r0 = b * TSEQ + n * 64;
  unsigned char* kimg = lds; unsigned char* qimg = lds + 16384; unsigned char* vimg = lds + 32768;
  unsigned char* Lbf = lds + 49152;
  float* Ld = (float*)(lds + 49152 + 8192);
  float* gcs = (float*)(lds + 49152 + 17408);
  float* egs = gcs + 64; float* bts = egs + 64;
  if (tid < 64) {
    float val = p.gbuf[(size_t)(r0 + tid) * 8 + h];
#pragma unroll
    for (int off = 1; off < 64; off <<= 1) { const float t = __shfl_up(val, off); if (lane >= off) val += t; }
    gcs[tid] = val; egs[tid] = __expf(val); bts[tid] = p.betabuf[(size_t)(r0 + tid) * 8 + h];
    p.gcbuf[(size_t)item * 64 + tid] = val;
  }
  {
    const int ch = tid & 15;
#pragma unroll
    for (int i = 0; i < 4; ++i) {
      const int row = (tid >> 4) + 16 * i; const size_t go = (size_t)(r0 + row) * DM + h * 128 + ch * 8; const unsigned lo = row * 256 + ((ch ^ (row & 15)) << 4);
      *(u32x4*)(kimg + lo) = *(const u32x4*)(p.kb + go); *(u32x4*)(qimg + lo) = *(const u32x4*)(p.qb + go); *(u32x4*)(vimg + lo) = *(const u32x4*)(p.vb + go);
    }
  }
  __syncthreads();
  {
#pragma unroll
    for (int nt = 0; nt < 4; ++nt) {
      f32x4 ck = (f32x4){0.f, 0.f, 0.f, 0.f}, cq = ck;
      if (nt <= w) {
#pragma unroll
        for (int ks = 0; ks < 4; ++ks) {
          const unsigned o = (16 * w + r16) * 256 + (((ks * 4 + quad) ^ r16) << 4);
          const bf16x8 ak = *(const bf16x8*)(kimg + o), aq = *(const bf16x8*)(qimg + o);
          const bf16x8 bk = *(const bf16x8*)(kimg + (16 * nt + r16) * 256 + (((ks * 4 + quad) ^ r16) << 4)); ck = mfma16(ak, bk, ck); cq = mfma16(aq, bk, cq); }
      }
      const int jc = 16 * nt + r16; const float gj = gcs[jc];
#pragma unroll
      for (int jj = 0; jj < 4; ++jj) {
        const int i = 16 * w + quad * 4 + jj;
        const float dec = (jc <= i) ? __expf(gcs[i] - gj) : 0.f;
        const float Lv = (jc < i) ? bts[i] * ck[jj] * dec : 0.f;
        if (nt == w) Ld[(w * 16 + quad * 4 + jj) * 16 + r16] = Lv;
        *(bf16_t*)(Lbf + img128(i, jc)) = (nt < w) ? f2bf(Lv) : (bf16_t)0;
        p.qkb[(size_t)item * 4096 + i * 64 + jc] = f2bf(cq[jj] * dec);
      }
    }
  }
  __syncthreads();
  {
    const int ch = tid & 15;
#pragma unroll
    for (int i = 0; i < 4; ++i) {
      const int row = (tid >> 4) + 16 * i; const float e = egs[row];
      const u32x4 qv = *(const u32x4*)(qimg + row * 256 + ((ch ^ (row & 15)) << 4));
      u32x4 o;
#pragma unroll
      for (int j = 0; j < 4; ++j) o[j] = pk_bf16(__uint_as_float(qv[j] << 16) * e, __uint_as_float(qv[j] & 0xffff0000u) * e);
      *(u32x4*)(p.qb + (size_t)(r0 + row) * DM + h * 128 + ch * 8) = o;
    }
    const int i = tid & 63; const float e = __expf(gcs[63] - gcs[i]);
#pragma unroll 4
    for (int m = 0; m < 32; ++m) {
      const int d = (tid >> 6) + 4 * m;
      const float kv = bf2f(*(const bf16_t*)(kimg + img256(i, d)));
      p.vb[(size_t)(r0 + (d >> 1)) * DM + h * 128 + (d & 1) * 64 + i] = f2bf(kv * e);
    }
  }
  {
    const int c = tid; const bool isv = c < 128; const int cl = c & 127;
    unsigned char* XT = lds + 16384;
    float* RT = (float*)lds;
    const int sw_ = (c >> 1) & 7;
    __syncthreads();
    if (isv) {
#pragma unroll
      for (int j8 = 0; j8 < 8; ++j8) {
        float t[8];
#pragma unroll
        for (int j = 0; j < 8; ++j) { const int i = j8 * 8 + j; t[j] = bts[i] * bf2f(*(const bf16_t*)(vimg + img256(i, cl))); }
        *(u32x4*)(XT + c * 128 + ((j8 ^ sw_) << 4)) = (u32x4){pk_bf16(t[0], t[1]), pk_bf16(t[2], t[3]), pk_bf16(t[4], t[5]), pk_bf16(t[6], t[7])};
      }
    }
    __syncthreads();
    if (!isv) {
#pragma unroll
      for (int j8 = 0; j8 < 8; ++j8) {
        float t[8];
#pragma unroll
        for (int j = 0; j < 8; ++j) { const int i = j8 * 8 + j; t[j] = bts[i] * egs[i] * bf2f(*(const bf16_t*)(kimg + img256(i, cl))); }
        *(u32x4*)(XT + c * 128 + ((j8 ^ sw_) << 4)) = (u32x4){pk_bf16(t[0], t[1]), pk_bf16(t[2], t[3]), pk_bf16(t[4], t[5]), pk_bf16(t[6], t[7])};
      }
    }
    __syncthreads();
#pragma unroll 1
    for (int r = 0; r < 4; ++r) {
      float xb[16];
      { const u32x4 lo = *(const u32x4*)(XT + c * 128 + (((2 * r) ^ sw_) << 4)), hi = *(const u32x4*)(XT + c * 128 + (((2 * r + 1) ^ sw_) << 4));
#pragma unroll
        for (int j = 0; j < 4; ++j) { xb[2 * j] = __uint_as_float(lo[j] << 16); xb[2 * j + 1] = __uint_as_float(lo[j] & 0xffff0000u); xb[8 + 2 * j] = __uint_as_float(hi[j] << 16); xb[8 + 2 * j + 1] = __uint_as_float(hi[j] & 0xffff0000u); } }
      if (r > 0) {
#pragma unroll
        for (int nt = 0; nt < 4; ++nt) {
          f32x4 accu = (f32x4){0.f, 0.f, 0.f, 0.f};
          const int ar = 16 * r + r16, br = 64 * w + 16 * nt + r16;
#pragma unroll
          for (int ks = 0; ks < 2; ++ks) {
            const bf16x8 av = *(const bf16x8*)(Lbf + ar * 128 + (((ks * 4 + quad) ^ ((ar >> 1) & 7)) << 4));
            const bf16x8 bv = *(const bf16x8*)(XT + br * 128 + (((ks * 4 + quad) ^ ((br >> 1) & 7)) << 4));
            accu = mfma16(av, bv, accu);
          }
          *(f32x4*)(RT + br * 16 + quad * 4) = accu;
        }
#pragma unroll
        for (int q4 = 0; q4 < 4; ++q4) { const f32x4 t = *(const f32x4*)(RT + c * 16 + q4 * 4); xb[q4 * 4] -= t[0]; xb[q4 * 4 + 1] -= t[1]; xb[q4 * 4 + 2] -= t[2]; xb[q4 * 4 + 3] -= t[3]; }
      }
#pragma unroll
      for (int i = 1; i < 16; ++i) {
        const float lrow = Ld[(r * 16 + i) * 16 + (lane & 15)];
        float a = xb[i];
#pragma unroll
        for (int j = 0; j < i; ++j) a -= __builtin_bit_cast(float, __builtin_amdgcn_readlane(__builtin_bit_cast(int, lrow), j)) * xb[j];
        xb[i] = a;
      }
      *(u32x4*)(XT + c * 128 + (((2 * r) ^ sw_) << 4)) = (u32x4){pk_bf16(xb[0], xb[1]), pk_bf16(xb[2], xb[3]), pk_bf16(xb[4], xb[5]), pk_bf16(xb[6], xb[7])};
      *(u32x4*)(XT + c * 128 + (((2 * r + 1) ^ sw_) << 4)) = (u32x4){pk_bf16(xb[8], xb[9]), pk_bf16(xb[10], xb[11]), pk_bf16(xb[12], xb[13]), pk_bf16(xb[14], xb[15])};
    }
    int item_o = item; asm volatile("" : "+s"(item_o));
    if (isv) {
      bf16_t* d = p.uT + ((size_t)item_o * 128 + cl) * 64;
#pragma unroll
      for (int j8 = 0; j8 < 8; ++j8) *(u32x4*)(d + j8 * 8) = *(const u32x4*)(XT + c * 128 + ((j8 ^ sw_) << 4));
    } else {
      bf16_t* d = p.win + (size_t)item_o * 8192 + cl;
#pragma unroll
      for (int j8 = 0; j8 < 8; ++j8) {
        const u32x4 v8 = *(const u32x4*)(XT + c * 128 + ((j8 ^ sw_) << 4));
#pragma unroll
        for (int j = 0; j < 4; ++j) { d[(j8 * 8 + 2 * j) * 128] = (bf16_t)(v8[j] & 0xffffu); d[(j8 * 8 + 2 * j + 1) * 128] = (bf16_t)(v8[j] >> 16); }
      }
    }
  }
  __syncthreads();
}

__device__ __forceinline__ void dn_sample_item(const Params& p, unsigned char* lds, int item) {
  const int tid = threadIdx.x, h = item & 7, b = item >> 3, v4 = (tid & 31) * 4, kq = tid >> 5, k0 = kq * 16;
  float* qf = (float*)lds; float* kf = qf + 128; float* red = kf + 128;
  const size_t row = (size_t)(MP + b);
  if (tid < 128) qf[tid] = bf2f(p.qb[row * DM + h * 128 + tid]); else kf[tid - 128] = bf2f(p.kb[row * DM + h * 128 + tid - 128]);
  const float eg = __expf(p.gbuf[row * 8 + h]), beta = p.betabuf[row * 8 + h];
  const u32x2 vraw = *(const u32x2*)(p.vb + row * DM + h * 128 + v4);
  const f32x4 vv = (f32x4){__uint_as_float(vraw[0] << 16), __uint_as_float(vraw[0] & 0xffff0000u), __uint_as_float(vraw[1] << 16), __uint_as_float(vraw[1] & 0xffff0000u)};
  const float* S = p.st_ssm + ((size_t)(b * 8 + h) * 128 + k0) * 128 + v4;
  f32x4 s[16];
#pragma unroll
  for (int k = 0; k < 16; ++k) s[k] = *(const f32x4*)(S + (size_t)k * 128);
  __syncthreads();
  f32x4 ks = (f32x4){0.f, 0.f, 0.f, 0.f}, qs = ks; float qk = 0.f;
#pragma unroll
  for (int k = 0; k < 16; ++k) { ks += s[k] * kf[k0 + k]; qs += s[k] * qf[k0 + k]; }
#pragma unroll 8
  for (int k = 0; k < 128; ++k) qk += qf[k] * kf[k];
  *(f32x4*)(red + kq * 256 + v4) = ks; *(f32x4*)(red + kq * 256 + 128 + v4) = qs;
  __syncthreads();
  f32x4 kst = (f32x4){0.f, 0.f, 0.f, 0.f}, qst = kst;
#pragma unroll
  for (int g = 0; g < 8; ++g) { kst += *(const f32x4*)(red + g * 256 + v4); qst += *(const f32x4*)(red + g * 256 + 128 + v4); }
  const f32x4 u = (vv - kst * eg) * beta;
  if (kq == 0) *(f32x4*)(p.osamp + (size_t)b * DM + h * 128 + v4) = qst * eg + u * qk;
  float* So = p.out + O_DNSS + ((size_t)(b * 8 + h) * 128 + k0) * 128 + v4;
#pragma unroll
  for (int k = 0; k < 16; ++k) *(f32x4*)(So + (size_t)k * 128) = s[k] * eg + u * kf[k0 + k];
  __syncthreads();
}

__device__ __forceinline__ void dn_pre_phase(const Params& p, unsigned char* lds) {
  for (int it = blockIdx.x; it < 2048; it += gridDim.x) dn_chunk_item(p, lds, it);
  for (int it = blockIdx.x; it < 1024; it += gridDim.x) dn_sample_item(p, lds, it);
}

__device__ __forceinline__ void dn_scan_phase(const Params& p, unsigned char* lds) {
  if (blockIdx.x >= 256) return;
  const int tid = threadIdx.x, lane = tid & 63, w = tid >> 6, r16 = lane & 15, quad = lane >> 4;
  const int xcd = blockIdx.x & 7, slot = blockIdx.x >> 3; const int pair = xcd * 8 + (slot >> 2), vs = slot & 3;
  const int b = pair >> 3, h = pair & 7;
  unsigned char* Wimg = lds; unsigned char* Qimg = lds + 16384; unsigned char* KTimg = lds + 32768; unsigned char* QKimg = lds + 49152;
  unsigned char* STimg = lds + 57344; unsigned char* UTimg = lds + 65536;
  for (int i = tid; i < 8192 / 16; i += 256) *(u32x4*)(STimg + i * 16) = (u32x4){0u, 0u, 0u, 0u};
  f32x4 accS[2][2];
#pragma unroll
  for (int a = 0; a < 2; ++a)
#pragma unroll
    for (int c = 0; c < 2; ++c) accS[a][c] = (f32x4){0.f, 0.f, 0.f, 0.f};
  u32x4 rw[4], rq[4], rk[4], rqk[2]; u32x2 ruc[2]; float gl_next;
  auto prefetch = [&](int n) {
    const int item = (b * 32 + n) * 8 + h; const int r0 = b * TSEQ + n * 64;
#pragma unroll
    for (int i = 0; i < 4; ++i) {
      const int q = tid + 256 * i;
      { const int row = q >> 4, ch = q & 15; rw[i] = *(const u32x4*)(p.win + (size_t)item * 8192 + row * 128 + ch * 8); rq[i] = *(const u32x4*)(p.qb + (size_t)(r0 + row) * DM + h * 128 + ch * 8); }
      { const int kidx = q >> 3, ch = q & 7; rk[i] = *(const u32x4*)(p.vb + (size_t)(r0 + (kidx >> 1)) * DM + h * 128 + (kidx & 1) * 64 + ch * 8); }
    }
#pragma unroll
    for (int i = 0; i < 2; ++i) { const int q = tid + 256 * i; const int row = q >> 3, ch = q & 7; rqk[i] = *(const u32x4*)(p.qkb + (size_t)item * 4096 + row * 64 + ch * 8); }
#pragma unroll
    for (int nt = 0; nt < 2; ++nt) ruc[nt] = *(const u32x2*)(p.uT + ((size_t)item * 128 + vs * 32 + nt * 16 + r16) * 64 + 16 * w + quad * 4);
    gl_next = p.gcbuf[(size_t)item * 64 + 63];
  };
  prefetch(0);
  for (int n = 0; n < 32; ++n) {
    const int item = (b * 32 + n) * 8 + h;
#pragma unroll
    for (int i = 0; i < 4; ++i) {
      const int q = tid + 256 * i;
      { const int row = q >> 4, ch = q & 15; const unsigned lo = row * 256 + ((ch ^ (row & 15)) << 4); *(u32x4*)(Wimg + lo) = rw[i]; *(u32x4*)(Qimg + lo) = rq[i]; }
      { const int kidx = q >> 3, ch = q & 7; *(u32x4*)(KTimg + kidx * 128 + ((ch ^ ((kidx >> 1) & 7)) << 4)) = rk[i]; }
    }
#pragma unroll
    for (int i = 0; i < 2; ++i) { const int q = tid + 256 * i; const int row = q >> 3, ch = q & 7; *(u32x4*)(QKimg + row * 128 + ((ch ^ ((row >> 1) & 7)) << 4)) = rqk[i]; }
    u32x2 uc[2] = {ruc[0], ruc[1]};
    const float egl = __expf(gl_next);
    __syncthreads();
    if (n + 1 < 32) prefetch(n + 1);
    f32x4 aWS[2], aQS[2];
#pragma unroll
    for (int nt = 0; nt < 2; ++nt) { aWS[nt] = (f32x4){0.f, 0.f, 0.f, 0.f}; aQS[nt] = aWS[nt]; }
#pragma unroll
    for (int ks = 0; ks < 4; ++ks) {
      const unsigned ao = (16 * w + r16) * 256 + (((ks * 4 + quad) ^ r16) << 4);
      const bf16x8 aw = *(const bf16x8*)(Wimg + ao), aq = *(const bf16x8*)(Qimg + ao);
#pragma unroll
      for (int nt = 0; nt < 2; ++nt) {
        const bf16x8 bs = *(const bf16x8*)(STimg + (nt * 16 + r16) * 256 + (((ks * 4 + quad) ^ r16) << 4));
        aWS[nt] = mfma16(aw, bs, aWS[nt]); aQS[nt] = mfma16(aq, bs, aQS[nt]);
      }
    }
#pragma unroll
    for (int nt = 0; nt < 2; ++nt) {
      const float u0 = __uint_as_float(uc[nt][0] << 16) - aWS[nt][0], u1 = __uint_as_float(uc[nt][0] & 0xffff0000u) - aWS[nt][1];
      const float u2 = __uint_as_float(uc[nt][1] << 16) - aWS[nt][2], u3 = __uint_as_float(uc[nt][1] & 0xffff0000u) - aWS[nt][3];
      const int v = nt * 16 + r16; const int chunk = 2 * w + (quad >> 1);
      *(u32x2*)(UTimg + v * 128 + ((chunk ^ ((v >> 1) & 7)) << 4) + (quad & 1) * 8) = (u32x2){pk_bf16(u0, u1), pk_bf16(u2, u3)};
    }
    __syncthreads();
    bf16x8 bu[2][2];
#pragma unroll
    for (int nt = 0; nt < 2; ++nt)
#pragma unroll
      for (int ks = 0; ks < 2; ++ks) { const int v = nt * 16 + r16; bu[nt][ks] = *(const bf16x8*)(UTimg + v * 128 + (((ks * 4 + quad) ^ ((v >> 1) & 7)) << 4)); }
#pragma unroll
    for (int ks = 0; ks < 2; ++ks) {
      const int row = 16 * w + r16;
      const bf16x8 aqk = *(const bf16x8*)(QKimg + row * 128 + (((ks * 4 + quad) ^ ((row >> 1) & 7)) << 4));
#pragma unroll
      for (int nt = 0; nt < 2; ++nt) aQS[nt] = mfma16(aqk, bu[nt][ks], aQS[nt]);
    }
#pragma unroll
    for (int nt = 0; nt < 2; ++nt)
      *(u32x2*)(p.uT + ((size_t)item * 128 + vs * 32 + nt * 16 + r16) * 64 + 16 * w + quad * 4) = (u32x2){pk_bf16(aQS[nt][0], aQS[nt][1]), pk_bf16(aQS[nt][2], aQS[nt][3])};
#pragma unroll
    for (int mt2 = 0; mt2 < 2; ++mt2) {
      const int mt = 2 * w + mt2; const int kidx = mt * 16 + r16;
#pragma unroll
      for (int nt = 0; nt < 2; ++nt) accS[mt2][nt] = accS[mt2][nt] * egl;
#pragma unroll
      for (int ks = 0; ks < 2; ++ks) {
        const bf16x8 akd = *(const bf16x8*)(KTimg + kidx * 128 + (((ks * 4 + quad) ^ ((kidx >> 1) & 7)) << 4));
#pragma unroll
        for (int nt = 0; nt < 2; ++nt) accS[mt2][nt] = mfma16(akd, bu[nt][ks], accS[mt2][nt]);
      }
#pragma unroll
      for (int nt = 0; nt < 2; ++nt) {
        const int v = nt * 16 + r16; const int chunk = 2 * mt + (quad >> 1);
        *(u32x2*)(STimg + v * 256 + ((chunk ^ (v & 15)) << 4) + (quad & 1) * 8) = (u32x2){pk_bf16(accS[mt2][nt][0], accS[mt2][nt][1]), pk_bf16(accS[mt2][nt][2], accS[mt2][nt][3])};
      }
    }
    __syncthreads();
  }
#pragma unroll
  for (int mt2 = 0; mt2 < 2; ++mt2)
#pragma unroll
    for (int nt = 0; nt < 2; ++nt)
#pragma unroll
      for (int jj = 0; jj < 4; ++jj) {
        const int kidx = (2 * w + mt2) * 16 + quad * 4 + jj, v = vs * 32 + nt * 16 + r16;
        p.out[O_DNSP + ((size_t)(b * 8 + h) * 128 + kidx) * 128 + v] = accS[mt2][nt][jj];
      }
}

__device__ __forceinline__ void dn_onorm_phase(const Params& p, unsigned char* lds) {
  const int tid = threadIdx.x;
  bf16_t* Ot = (bf16_t*)lds;
  float* red = (float*)(lds + 128 * 66 * 2);
  for (int it = blockIdx.x; it < 2048 + 128; it += gridDim.x) {
    if (it < 2048) {
      const int item = it, h = item & 7, n = (item >> 3) & 31, b = item >> 8, r0 = b * TSEQ + n * 64;
#pragma unroll
      for (int i = 0; i < 4; ++i) {
        const int q = tid + 256 * i, v = q >> 3, ch = q & 7;
        const u32x4 d = *(const u32x4*)(p.uT + (size_t)item * 8192 + v * 64 + ch * 8);
        unsigned* dst = (unsigned*)(Ot + v * 66 + ch * 8);
        dst[0] = d[0]; dst[1] = d[1]; dst[2] = d[2]; dst[3] = d[3];
      }
      __syncthreads();
      { const int i = tid & 63, vq = tid >> 6; float s = 0.f;
#pragma unroll 8
        for (int v = vq * 32; v < vq * 32 + 32; ++v) { const float o = bf2f(Ot[v * 66 + i]); s += o * o; }
        red[vq * 64 + i] = s; }
      __syncthreads();
      {
#pragma unroll
        for (int m = 0; m < 4; ++m) {
          const int q = tid + 256 * m, i = q >> 4, v8 = (q & 15) * 8;
          const float rs = rsqrtf((red[i] + red[64 + i] + red[128 + i] + red[192 + i]) * (1.f / 128.f) + 1e-6f);
          const size_t go = (size_t)(r0 + i) * DM + h * 128 + v8;
          const u32x4 zz = *(const u32x4*)(p.zb + go);
          const f32x4 w0 = *(const f32x4*)(p.dn_o_norm_w + v8), w1 = *(const f32x4*)(p.dn_o_norm_w + v8 + 4);
          float r[8];
#pragma unroll
          for (int j = 0; j < 8; ++j) {
            const float z = (j & 1) ? __uint_as_float(zz[j >> 1] & 0xffff0000u) : __uint_as_float(zz[j >> 1] << 16);
            r[j] = bf2f(Ot[(v8 + j) * 66 + i]) * rs * (j < 4 ? w0[j & 3] : w1[j & 3]) * silu_f(z);
          }
          *(u32x4*)(p.actA + go) = (u32x4){pk_bf16(r[0], r[1]), pk_bf16(r[2], r[3]), pk_bf16(r[4], r[5]), pk_bf16(r[6], r[7])};
        }
      }
      __syncthreads();
    } else {
      const int b = it - 2048; const int c = tid * 4;
      const f32x4 o = *(const f32x4*)(p.osamp + (size_t)b * DM + c);
      float s = o[0] * o[0] + o[1] * o[1] + o[2] * o[2] + o[3] * o[3];
#pragma unroll
      for (int m = 16; m >= 1; m >>= 1) s += __shfl_xor(s, m);
      const float rs = rsqrtf(s * (1.f / 128.f) + 1e-6f);
      const f32x4 ow = *(const f32x4*)(p.dn_o_norm_w + (c & 127));
      const size_t go = (size_t)(MP + b) * DM + c;
      const u32x2 zz = *(const u32x2*)(p.zb + go);
      const float z0 = __uint_as_float(zz[0] << 16), z1 = __uint_as_float(zz[0] & 0xffff0000u), z2 = __uint_as_float(zz[1] << 16), z3 = __uint_as_float(zz[1] & 0xffff0000u);
      *(u32x2*)(p.actA + go) = (u32x2){pk_bf16(o[0] * rs * ow[0] * silu_f(z0), o[1] * rs * ow[1] * silu_f(z1)), pk_bf16(o[2] * rs * ow[2] * silu_f(z2), o[3] * rs * ow[3] * silu_f(z3))};
    }
  }
}

#define XB_XCNT(j) (64 * (j))
#define XB_XSUB(j) (1024 + 64 * (j))
#define XB_XGEN(j) (2048 + 64 * (j))
#define XB_TOP     3072
#define XB_TOPGEN  3136
#define XB_WORDS   3200
#define XB_SPIN_CAP (1u << 24)
__device__ __forceinline__ unsigned xb_ld(unsigned* q) { return __hip_atomic_load(q, __ATOMIC_RELAXED, __HIP_MEMORY_SCOPE_AGENT); }
__device__ __forceinline__ unsigned xb_add(unsigned* q, unsigned v) { return __hip_atomic_fetch_add(q, v, __ATOMIC_RELAXED, __HIP_MEMORY_SCOPE_AGENT); }
__device__ __forceinline__ unsigned xb_xcc_id() { return (unsigned)__builtin_amdgcn_s_getreg((3 << 11) | 20) & 0xFu; }
struct XBar { unsigned* bar; unsigned x; volatile unsigned* st; };
__device__ __forceinline__ void grid_barrier(const XBar& b) {
  asm volatile("s_waitcnt vmcnt(0)" ::: "memory");
  __syncthreads();
  if (threadIdx.x == 0) {
    unsigned* bar = b.bar;
    unsigned nloc = b.st[0], nx = b.st[1];
    if (nloc == 0u) {
      const unsigned G = gridDim.x; unsigned sp = 0;
      for (;;) {
        unsigned sum = 0, cnt = 0, mine = 0;
#pragma unroll
        for (unsigned j = 0; j < 16; ++j) { const unsigned c = xb_ld(&bar[XB_XCNT(j)]); sum += c; cnt += (c > 0u) ? 1u : 0u; mine = (j == b.x) ? c : mine; }
        nloc = mine > 0u ? mine : 1u; nx = cnt > 0u ? cnt : 1u;
        if (sum == G || ++sp > XB_SPIN_CAP) break;
        __builtin_amdgcn_s_sleep(2);
      }
      b.st[0] = nloc; b.st[1] = nx;
    }
    const unsigned old = xb_add(&bar[XB_XSUB(b.x)], 1u);
    const unsigned gen = old / nloc;
    if (old + 1u == (gen + 1u) * nloc) {
      __builtin_amdgcn_fence(__ATOMIC_RELEASE, "agent");
      asm volatile("s_waitcnt vmcnt(0)" ::: "memory");
      const unsigned og = xb_add(&bar[XB_TOP], 1u);
      const unsigned tg = og / nx;
      if (og + 1u == (tg + 1u) * nx) xb_add(&bar[XB_TOPGEN], 1u);
      else { unsigned sp = 0; while (xb_ld(&bar[XB_TOPGEN]) == tg && ++sp < XB_SPIN_CAP) __builtin_amdgcn_s_sleep(2); }
      __builtin_amdgcn_fence(__ATOMIC_ACQUIRE, "agent");
      xb_add(&bar[XB_XGEN(b.x)], 1u);
      asm volatile("s_waitcnt vmcnt(0)" ::: "memory");
    } else {
      unsigned sp = 0; while (xb_ld(&bar[XB_XGEN(b.x)]) == gen && ++sp < XB_SPIN_CAP) __builtin_amdgcn_s_sleep(2);
      __builtin_amdgcn_fence(__ATOMIC_ACQUIRE, "agent");
      asm volatile("s_waitcnt vmcnt(0)" ::: "memory");
    }
  }
  __syncthreads();
}

constexpr int NPHASE = 16;
__global__ void __launch_bounds__(256, 2) mega(Params p) {
  __shared__ __attribute__((aligned(16))) unsigned char lds[LDS_BYTES + 16];
  cg::grid_group grid = cg::this_grid();
  if (p.phase_lo < 0) grid.sync();
  XBar xb; xb.bar = p.bar; xb.x = xb_xcc_id(); xb.st = (volatile unsigned*)(lds + LDS_BYTES);
  if (threadIdx.x == 0) { xb.st[0] = 0u; xb.st[1] = 0u; (void)xb_add(&p.bar[XB_XCNT(xb.x)], 1u); }
  __syncthreads();
#define PHASE(k, call) if (p.phase_lo <= (k) && (k) < p.phase_hi) { call; if ((k) + 1 < p.phase_hi) grid_barrier(xb); }
  PHASE(0, phase0(p, lds))
  PHASE(1, phase1(p))
  PHASE(2, gemm_rows_phase<0>(p, lds, p.actA, DM, p.WpoolT, 256, 1))
  PHASE(3, norm_to_bf16(p, p.norm2_w, 0))
  PHASE(4, ffn_up_phase(p, lds, 0))
  PHASE(5, gemm_rows_phase<1>(p, lds, p.act, DFF, p.WdnT0, DFF, 11))
  PHASE(6, norm_to_bf16(p, p.norm1_w + DM, 11))
  PHASE(7, dn_in_phase(p, lds))
  PHASE(8, dn_pre_phase(p, lds))
  PHASE(9, dn_scan_phase(p, lds))
  PHASE(10, dn_onorm_phase(p, lds))
  PHASE(11, gemm_rows_phase<1>(p, lds, p.actA, DM, p.WoutT, DM, 4))
  PHASE(12, norm_to_bf16(p, p.norm2_w + DM, 4))
  PHASE(13, ffn_up_phase(p, lds, 1))
  PHASE(14, gemm_rows_phase<1>(p, lds, p.act, DFF, p.WdnT1, DFF, 11))
  PHASE(15, final_norm(p, 11))
}

extern "C" void kernel_launch(void* const* d_in, const int* in_sizes, int n_in, void* d_out, int out_size, void* d_ws, size_t ws_size, hipStream_t stream) {
  static int grid_blocks = 0;
  if (!grid_blocks) {
    int dev = 0, cus = 0, per_cu = 0;
    hipGetDevice(&dev);
    hipDeviceGetAttribute(&cus, hipDeviceAttributeMultiprocessorCount, dev);
    hipOccupancyMaxActiveBlocksPerMultiprocessor(&per_cu, mega, 256, 0);
    if (per_cu > 2) per_cu = 2;
    grid_blocks = cus * per_cu;
    if (grid_blocks < 256 || (grid_blocks & 7)) fprintf(stderr, "unexpected grid %d\n", grid_blocks);
  }
  Params p{};
  const float* const* in = (const float* const*)d_in;
  p.xp = in[0]; p.xs = in[1]; p.st_pool = in[2]; p.st_dnc = in[3]; p.st_ssm = in[4]; p.st_ffn = in[5];
  p.norm1_w = in[6]; p.norm2_w = in[7]; p.final_w = in[8]; p.pool_w = in[9]; p.pool_scale = in[10]; p.dn_w_in = in[11]; p.dn_conv_w = in[12];
  p.dn_a_log = in[13]; p.dn_dt_bias = in[14]; p.dn_o_norm_w = in[15]; p.dn_w_out = in[16]; p.ffn_w_up = in[17]; p.ffn_conv_w = in[18]; p.ffn_conv_b = in[19]; p.ffn_w_down = in[20];
  p.out = (float*)d_out;
  unsigned char* ws = (unsigned char*)d_ws; size_t off = 0;
  auto take = [&](size_t bytes) { unsigned char* r = ws + off; off += (bytes + 255) & ~(size_t)255; return r; };
  unsigned char* w0 = take((size_t)4 * 65536 * 2 + (size_t)DFF2 * DM * 2 + (size_t)DM * DFF * 2);
  p.WpoolT = (bf16_t*)w0; p.WupT0 = (bf16_t*)(w0 + (size_t)4 * 65536 * 2); p.WdnT0 = (bf16_t*)(w0 + (size_t)4 * 65536 * 2 + (size_t)DFF2 * DM * 2);
  p.qkb = (bf16_t*)w0;
  p.WupT1 = (bf16_t*)take((size_t)DFF2 * DM * 2); p.WdnT1 = (bf16_t*)take((size_t)DM * DFF * 2);
  p.WinT = (bf16_t*)take((size_t)DNIN_PAD * DM * 2); p.WoutT = (bf16_t*)take((size_t)DM * DM * 2);
  p.bar = (unsigned*)take((size_t)XB_WORDS * 4);
  p.rstd = (float*)take((size_t)MTOT * 4); p.gbuf = (float*)take((size_t)MTOT * 8 * 4); p.betabuf = (float*)take((size_t)MTOT * 8 * 4);
  p.gcbuf = (float*)take((size_t)2048 * 64 * 4); p.osamp = (float*)take((size_t)MS * DM * 4); p.part = (float*)take((size_t)11 * MS * DM * 4);
  p.actA = (bf16_t*)take((size_t)MTOT * DM * 2); p.win = p.actA;
  unsigned char* big = take(0); const size_t big_off = off;
  p.act = (bf16_t*)big;
  const size_t bsz = (size_t)MTOT * DM * 2;
  p.qb = (bf16_t*)big; p.kb = (bf16_t*)(big + bsz); p.vb = (bf16_t*)(big + 2 * bsz); p.zb = (bf16_t*)(big + 3 * bsz); p.uT = (bf16_t*)(big + 4 * bsz);
  const size_t need = big_off + 4 * bsz + (size_t)2048 * 8192 * 2;
  if (need > ws_size || big_off + (size_t)MTOT * DFF * 2 > ws_size) { fprintf(stderr, "workspace too small: need %zu have %zu\n", need, ws_size); return; }
  p.phase_lo = 0; p.phase_hi = NPHASE;
  hipMemsetAsync(p.bar, 0, (size_t)XB_WORDS * 4, stream);
  void* args[] = {&p};
  hipError_t e = hipLaunchCooperativeKernel((void*)mega, dim3(grid_blocks), dim3(256), args, 0, stream);
  if (e != hipSuccess) fprintf(stderr, "cooperative launch failed: %s (grid %d)\n", hipGetErrorString(e), grid_blocks);
}
```
